# Optimizing an MI355X kernel written in HIP

```python
import jax, jax.numpy as jnp
from jax import lax
import numpy as np

D_MODEL = 2048
BATCH = 2
SEQ = 4096
DEPTH = 4

RET_HEADS = 8
RET_QK_DIM = 128
RET_V_DIM = 256
RET_QK_WIDTH = RET_HEADS * RET_QK_DIM
RET_V_WIDTH = RET_HEADS * RET_V_DIM
RET_CHUNK = 128
ROPE_BASE = 10000.0
POOL_WINDOWS = (2, 4, 8, 16)
POOL_GROUPS = len(POOL_WINDOWS)
POOL_GROUP_DIM = D_MODEL // 8
POOL_WIDTH = POOL_GROUPS * POOL_GROUP_DIM
N_BRANCHES = 2
IN_SPLITS = (
    RET_QK_WIDTH,
    2 * RET_QK_WIDTH,
    2 * RET_QK_WIDTH + RET_V_WIDTH,
    2 * RET_QK_WIDTH + 2 * RET_V_WIDTH,
    2 * RET_QK_WIDTH + 2 * RET_V_WIDTH + POOL_WIDTH,
)
IN_WIDTH = 2 * RET_QK_WIDTH + 2 * RET_V_WIDTH + POOL_WIDTH + N_BRANCHES * D_MODEL
D_FF = ((8 * D_MODEL + 3 * 256 - 1) // (3 * 256)) * 256
NORM_EPS = 1e-6

kernel_name = "hybrid_retention_pool_gated_block"


def rmsnorm(x, g):
    xf = x.astype(jnp.float32)
    xf = xf * lax.rsqrt(jnp.mean(xf * xf, axis=-1, keepdims=True) + NORM_EPS)
    return (xf * g.astype(jnp.float32)).astype(x.dtype)


def rotary(t, positions):
    half = t.shape[-1] // 2
    inv_freq = ROPE_BASE ** (-jnp.arange(half, dtype=jnp.float32) / half)
    ang = positions.astype(jnp.float32)[..., None] * inv_freq
    cos = jnp.cos(ang)[:, :, None, :].astype(t.dtype)
    sin = jnp.sin(ang)[:, :, None, :].astype(t.dtype)
    t1, t2 = t[..., :half], t[..., half:]
    return jnp.concatenate([t1 * cos - t2 * sin, t2 * cos + t1 * sin], axis=-1)


def retention_chunkwise(q, k, v):
    b, s, h, dk = q.shape
    dv = v.shape[-1]
    n = s // RET_CHUNK
    c = RET_CHUNK
    dt = q.dtype
    qc = q.reshape(b, n, c, h, dk).transpose(0, 3, 1, 2, 4)
    kc = k.reshape(b, n, c, h, dk).transpose(0, 3, 1, 2, 4)
    vc = v.reshape(b, n, c, h, dv).transpose(0, 3, 1, 2, 4)
    log_gamma = jnp.log(1.0 - 2.0 ** (-5.0 - jnp.arange(h, dtype=jnp.float32)))
    idx = jnp.arange(c, dtype=jnp.float32)
    diff = idx[:, None] - idx[None, :]
    decay_mask = jnp.where(diff[None] >= 0,
                           jnp.exp(jnp.maximum(diff, 0.0)[None] * log_gamma[:, None, None]),
                           0.0).astype(dt)
    xi = jnp.exp((idx + 1.0)[None, :] * log_gamma[:, None]).astype(dt)
    zeta = jnp.exp((c - 1.0 - idx)[None, :] * log_gamma[:, None]).astype(dt)
    chunk_decay = jnp.exp(c * log_gamma).astype(dt)
    scores = jnp.einsum('bhncd,bhnmd->bhncm', qc, kc) * decay_mask[None, :, None]
    intra = jnp.einsum('bhncm,bhnme->bhnce', scores, vc)
    kv = jnp.einsum('bhncd,bhnce->bhnde', kc * zeta[None, :, None, :, None], vc)

    def step(state, kv_i):
        new_state = state * chunk_decay[None, :, None, None] + kv_i
        return new_state, state

    init = jnp.zeros((b, h, dk, dv), dtype=kv.dtype)
    _, prev_states = lax.scan(step, init, jnp.moveaxis(kv, 2, 0))
    prev_states = jnp.moveaxis(prev_states, 0, 2)
    cross = jnp.einsum('bhncd,bhnde->bhnce', qc * xi[None, :, None, :, None], prev_states)
    y = (intra + cross).reshape(b, h, s, dv)
    yf = y.astype(jnp.float32)
    yf = yf * lax.rsqrt(jnp.mean(yf * yf, axis=-1, keepdims=True) + NORM_EPS)
    return yf.astype(dt).transpose(0, 2, 1, 3)


def causal_multiscale_pool(u, pool_mix, pool_scale):
    b, s, _ = u.shape
    ug = u.reshape(b, s, POOL_GROUPS, POOL_GROUP_DIM)
    cs = jnp.cumsum(ug.astype(jnp.float32), axis=1)
    cs0 = jnp.concatenate([jnp.zeros((b, 1, POOL_GROUPS, POOL_GROUP_DIM), jnp.float32), cs], axis=1)
    t = jnp.arange(s, dtype=jnp.float32)
    pooled = []
    for gi, w in enumerate(POOL_WINDOWS):
        upper = cs0[:, 1:, gi]
        lower = jnp.concatenate([jnp.zeros((b, w - 1, POOL_GROUP_DIM), jnp.float32),
                                 cs0[:, :s + 1 - w, gi]], axis=1)
        count = jnp.minimum(t + 1.0, float(w))[None, :, None]
        pooled.append((upper - lower) / count - ug[:, :, gi].astype(jnp.float32))
    pooled = jnp.stack(pooled, axis=2).astype(u.dtype)
    mixed = jnp.einsum('bsgc,gcd->bsgd', pooled, pool_mix)
    return mixed.reshape(b, s, POOL_WIDTH) * pool_scale


def setup_inputs(seed: int = 0) -> dict:
    key = jax.random.key(seed)
    ks = jax.random.split(key, 14)
    f32 = jnp.float32

    def nrm(k, shape, fan_in):
        return jax.random.normal(k, shape, f32) * (fan_in ** -0.5)

    def gain(k, shape):
        return 1.0 + 0.02 * jax.random.normal(k, shape, f32)

    x = jax.random.normal(ks[0], (BATCH, SEQ, D_MODEL), f32)
    positions = jnp.broadcast_to(jnp.arange(SEQ, dtype=jnp.int32)[None, :], (BATCH, SEQ))
    return {
        "x": x,
        "positions": positions,
        "norm1": gain(ks[1], (DEPTH, D_MODEL)),
        "w_in": nrm(ks[2], (DEPTH, D_MODEL, IN_WIDTH), D_MODEL),
        "pool_mix": nrm(ks[3], (DEPTH, POOL_GROUPS, POOL_GROUP_DIM, POOL_GROUP_DIM), POOL_GROUP_DIM),
        "pool_scale": gain(ks[4], (DEPTH, POOL_WIDTH)),
        "w_ret_up": nrm(ks[5], (DEPTH, RET_V_WIDTH, D_MODEL), RET_V_WIDTH),
        "w_pool_up": nrm(ks[6], (DEPTH, POOL_WIDTH, D_MODEL), POOL_WIDTH),
        "w_o": nrm(ks[7], (DEPTH, D_MODEL, D_MODEL), D_MODEL),
        "norm2": gain(ks[8], (DEPTH, D_MODEL)),
        "w_gu": nrm(ks[9], (DEPTH, D_MODEL, 2 * D_FF), D_MODEL),
        "w_down": nrm(ks[10], (DEPTH, D_FF, D_MODEL), D_FF),
        "norm_f": gain(ks[11], (D_MODEL,)),
    }


def reference(x, positions, norm1, w_in, pool_mix, pool_scale, w_ret_up, w_pool_up, w_o,
              norm2, w_gu, w_down, norm_f):
    b, s, _ = x.shape
    q_scale = RET_QK_DIM ** -0.5
    for l in range(DEPTH):
        xn = rmsnorm(x, norm1[l])
        proj = xn @ w_in[l]
        q, k, v, g_ret, u_pool, gate_logits = jnp.split(proj, IN_SPLITS, axis=-1)
        q = rotary(q.reshape(b, s, RET_HEADS, RET_QK_DIM), positions) * q_scale
        k = rotary(k.reshape(b, s, RET_HEADS, RET_QK_DIM), positions)
        v = v.reshape(b, s, RET_HEADS, RET_V_DIM)
        y_ret = retention_chunkwise(q, k, v).reshape(b, s, RET_V_WIDTH) * jax.nn.silu(g_ret)
        y_pool = causal_multiscale_pool(u_pool, pool_mix[l], pool_scale[l])
        gates = jax.nn.sigmoid(gate_logits.reshape(b, s, N_BRANCHES, D_MODEL))
        merged = gates[:, :, 0] * (y_ret @ w_ret_up[l]) + gates[:, :, 1] * (y_pool @ w_pool_up[l])
        x = x + merged @ w_o[l]
        xn2 = rmsnorm(x, norm2[l])
        gate_h, up_h = jnp.split(xn2 @ w_gu[l], 2, axis=-1)
        x = x + (jax.nn.silu(gate_h) * up_h) @ w_down[l]
    return rmsnorm(x, norm_f)
```

```cpp
#define MK_LAUNCHES 1
#define MK_REPEAT_MASK 0
#define MK_CONVERT_UPFRONT 0
#define MK_NAIVE_MASK 0
#include <hip/hip_runtime.h>
#include <stdint.h>
#include <stdio.h>

#define LAS __attribute__((address_space(3)))
typedef unsigned short bf16_t;
typedef short bf16x8 __attribute__((ext_vector_type(8)));
typedef float f32x4 __attribute__((ext_vector_type(4)));
typedef unsigned u32x4 __attribute__((ext_vector_type(4)));
typedef unsigned u32x2 __attribute__((ext_vector_type(2)));

constexpr int D = 2048, NB = 2, SEQ = 4096, M = NB * SEQ, DEPTH = 4;
constexpr int HEADS = 8, DK = 128, DV = 256, QKW = 1024, VW = 2048, CHUNK = 128, NCH = SEQ / CHUNK;
constexpr int PW = 1024, PG = 4, PGD = 256;
constexpr int INW = 11264, DFF = 5632, GUW = 2 * DFF;
constexpr float NORM_EPS = 1e-6f;
constexpr float Q_SCALE = 0.08838834764831845f;

constexpr size_t MiB = 1u << 20;
constexpr size_t WS_CTL = 0, CTL_ZERO_BYTES = 1 * MiB;
constexpr size_t WS_TRIG = 1 * MiB;
constexpr size_t WS_W = 8 * MiB, W_STRIDE = 131 * MiB;
constexpr size_t WO_IN = 0, WO_GU = 44 * MiB, WO_D = 88 * MiB, WO_RU = 110 * MiB, WO_PU = 118 * MiB, WO_O = 122 * MiB, WO_PM = 130 * MiB;
constexpr size_t WS_X = 532 * MiB;
constexpr size_t WS_XN = 596 * MiB;
constexpr size_t WS_B = 628 * MiB;
constexpr size_t WS_Q = WS_B, WS_K = WS_Q + 16 * MiB, WS_KT = WS_K + 16 * MiB, WS_VT = WS_KT + 16 * MiB, WS_GR = WS_VT + 32 * MiB, WS_U = WS_GR + 32 * MiB,
                 WS_G = WS_U + 16 * MiB, WS_ST = WS_G + 64 * MiB, WS_PO = WS_ST + 32 * MiB, WS_YP = WS_PO + 16 * MiB, WS_YR = WS_YP + 16 * MiB,
                 WS_T1 = WS_YR + 32 * MiB, WS_MG = WS_T1 + 64 * MiB, WS_BEND = WS_MG + 32 * MiB;
constexpr size_t WS_H = WS_B;
constexpr size_t WS_TMP = WS_BEND;
static_assert(WS_BEND == 1012 * MiB, "map");
constexpr int CW_BAR = 4096;

__device__ __forceinline__ float bf2f(bf16_t v) { return __uint_as_float(((unsigned)v) << 16); }
__device__ __forceinline__ bf16_t f2bf(float f) { unsigned u = __float_as_uint(f); u += 0x7fffu + ((u >> 16) & 1u); return (bf16_t)(u >> 16); }
__device__ __forceinline__ unsigned pk2(float lo, float hi) { return (unsigned)f2bf(lo) | ((unsigned)f2bf(hi) << 16); }
__device__ __forceinline__ float silu_f(float x) { return x / (1.0f + __expf(-x)); }
__device__ __forceinline__ float sigmoid_f(float x) { return 1.0f / (1.0f + __expf(-x)); }
__device__ __forceinline__ float wave_sum(float v) {
#pragma unroll
    for (int o = 1; o < 64; o <<= 1) v += __shfl_xor(v, o);
    return v;
}
__host__ __device__ __forceinline__ int map_row(int mode, int n) {
    if (mode == 1) { if (n >= 2 * QKW) return n; const int sec = n / QKW, w = n % QKW, head = w / DK, p = (w % DK) / 64, i = w % 64; return sec * QKW + (head >> 1) * 256 + 128 * p + (head & 1) * 64 + i; }
    if (mode == 2) { const int p = n / DFF, j = n % DFF; return (j / 128) * 256 + 128 * p + (j % 128); }
    return n;
}

constexpr int TR_SCR_BYTES = 64 * 65 * 4;
__device__ __forceinline__ void transpose_item(const float* W, int K, int N, bf16_t* WT, int mode, const float* nscale, LAS float* scr, int item, int lane) {
    const int kblk = K / 64, nb = item / kblk, kb = item % kblk, k0 = 64 * kb, n0 = 64 * nb;
    const float* src = W + (size_t)(k0 + (lane >> 4)) * N + n0 + 4 * (lane & 15);
    f32x4 v[16];
#pragma unroll
    for (int i = 0; i < 16; ++i) v[i] = *(const f32x4*)(src + (size_t)(4 * i) * N);
    LAS float* d = scr + (lane >> 4) * 65 + 4 * (lane & 15);
#pragma unroll
    for (int i = 0; i < 16; ++i) { d[(4 * i) * 65 + 0] = v[i].x; d[(4 * i) * 65 + 1] = v[i].y; d[(4 * i) * 65 + 2] = v[i].z; d[(4 * i) * 65 + 3] = v[i].w; }
    asm volatile("s_waitcnt lgkmcnt(0)" ::: "memory");
    const int c = lane & 7, d0 = map_row(mode, n0);
#pragma unroll
    for (int j = 0; j < 8; ++j) { const int n = (lane >> 3) + 8 * j; const LAS float* s = scr + (8 * c) * 65 + n; const float sc = nscale ? nscale[n0 + n] : 1.0f;
        u32x4 o; o.x = pk2(s[0 * 65] * sc, s[1 * 65] * sc); o.y = pk2(s[2 * 65] * sc, s[3 * 65] * sc); o.z = pk2(s[4 * 65] * sc, s[5 * 65] * sc); o.w = pk2(s[6 * 65] * sc, s[7 * 65] * sc);
        *(u32x4*)(WT + (size_t)(d0 + n) * K + k0 + 8 * c) = o; }
    asm volatile("s_waitcnt lgkmcnt(0)" ::: "memory");
}
constexpr int I_IN = (D / 64) * (INW / 64), I_GU = (D / 64) * (GUW / 64), I_D = (DFF / 64) * (D / 64), I_RU = (VW / 64) * (D / 64), I_PU = (PW / 64) * (D / 64), I_O = (D / 64) * (D / 64), I_PM = PG * (PGD / 64) * (PGD / 64);
constexpr int I_SETA = I_IN + I_RU + I_PU + I_O + I_PM;
constexpr int I_PER = I_SETA + I_GU + I_D;
__device__ __forceinline__ void convert_item(const float* const* in, unsigned char* ws, LAS float* scr, int l, int r, int lane) {
    unsigned char* wl = ws + WS_W + (size_t)l * W_STRIDE;
    if (r < I_IN) { transpose_item(in[3] + (size_t)l * D * INW, D, INW, (bf16_t*)(wl + WO_IN), 1, nullptr, scr, r, lane); return; } r -= I_IN;
    if (r < I_RU) { transpose_item(in[6] + (size_t)l * VW * D, VW, D, (bf16_t*)(wl + WO_RU), 0, nullptr, scr, r, lane); return; } r -= I_RU;
    if (r < I_PU) { transpose_item(in[7] + (size_t)l * PW * D, PW, D, (bf16_t*)(wl + WO_PU), 0, nullptr, scr, r, lane); return; } r -= I_PU;
    if (r < I_O) { transpose_item(in[8] + (size_t)l * D * D, D, D, (bf16_t*)(wl + WO_O), 0, nullptr, scr, r, lane); return; } r -= I_O;
    if (r < I_PM) { const int g = r / ((PGD / 64) * (PGD / 64)), rr = r % ((PGD / 64) * (PGD / 64));
      transpose_item(in[4] + ((size_t)l * PG + g) * PGD * PGD, PGD, PGD, (bf16_t*)(wl + WO_PM) + (size_t)g * PGD * PGD, 0, in[5] + (size_t)l * PW + g * PGD, scr, rr, lane); return; } r -= I_PM;
    if (r < I_GU) { transpose_item(in[10] + (size_t)l * D * GUW, D, GUW, (bf16_t*)(wl + WO_GU), 2, nullptr, scr, r, lane); return; } r -= I_GU;
    transpose_item(in[11] + (size_t)l * DFF * D, DFF, D, (bf16_t*)(wl + WO_D), 0, nullptr, scr, r, lane);
}
__device__ __forceinline__ void trig_item(const int* positions, float* T, int idx) {
    const int token = idx >> 6, i = idx & 63;
    const int pos = positions[token];
    const float inv_freq = (float)exp2(-(double)i / 64.0 * 13.287712379549449);
    const float ang = (float)pos * inv_freq;
    const double x = (double)ang, k = rint(x * 0.63661977236758134308);
    double r = fma(-k, 1.57079632679489655800, x); r = fma(-k, 6.12323399573676603587e-17, r);
    const int q = ((int)k) & 3; const double r2 = r * r;
    const double sp = r * (1.0 + r2 * (-1.0 / 6 + r2 * (1.0 / 120 + r2 * (-1.0 / 5040 + r2 * (1.0 / 362880 + r2 * (-1.0 / 39916800 + r2 * (1.0 / 6227020800.0)))))));
    const double cp = 1.0 + r2 * (-0.5 + r2 * (1.0 / 24 + r2 * (-1.0 / 720 + r2 * (1.0 / 40320 + r2 * (-1.0 / 3628800 + r2 * (1.0 / 479001600 + r2 * (-1.0 / 87178291200.0)))))));
    double s, c;
    if (q == 0) { s = sp; c = cp; } else if (q == 1) { s = cp; c = -sp; } else if (q == 2) { s = -sp; c = -cp; } else { s = -cp; c = sp; }
    T[2 * idx] = (float)c; T[2 * idx + 1] = (float)s;
}
__device__ __forceinline__ void rmsnorm_row(const float* xrow, const float* g, bf16_t* orow, float* frow, int lane) {
    const f32x4* xr = (const f32x4*)xrow + lane; const f32x4* gr = (const f32x4*)g + lane;
    f32x4 v[8]; float s = 0.f;
#pragma unroll
    for (int j = 0; j < 8; ++j) { v[j] = xr[64 * j]; s += (v[j].x * v[j].x + v[j].y * v[j].y) + (v[j].z * v[j].z + v[j].w * v[j].w); }
    const float rstd = rsqrtf(wave_sum(s) * (1.0f / D) + NORM_EPS);
#pragma unroll
    for (int j = 0; j < 8; ++j) { const f32x4 gg = gr[64 * j]; const f32x4 o = v[j] * rstd * gg;
        if (orow) { u32x2 w; w.x = pk2(o.x, o.y); w.y = pk2(o.z, o.w); *((u32x2*)orow + lane + 64 * j) = w; }
        else *((f32x4*)frow + lane + 64 * j) = o; }
}
namespace pg8 {
#define PG8_LAS __attribute__((address_space(3)))
typedef unsigned short bf16_t;
typedef short bf16x8 __attribute__((ext_vector_type(8)));
typedef float f32x4 __attribute__((ext_vector_type(4)));
typedef unsigned u32x4 __attribute__((ext_vector_type(4)));
constexpr int BM = 256, BK = 64, HALF = 128, HTB = HALF * BK * 2  , STAGE_BYTES = 8 * HTB, NXCD = 8, WGM = 8;

__host__ __device__ __forceinline__ int lds_byte(int r, int c) { const int st = (r >> 4) * 2 + (c >> 5), rr = r & 15, cc = c & 31, ob = rr * 64 + cc * 2; return st * 1024 + (ob ^ (((ob >> 9) & 1) << 5)); }
__host__ __device__ __forceinline__ void stage_rc(int b, int& R, int& C) { const int st = b / 1024, sb = b % 1024, swz = sb ^ (((sb >> 9) & 1) << 5); R = (st >> 1) * 16 + swz / 64; C = (st & 1) * 32 + (swz % 64) / 2; }
__host__ __device__ __forceinline__ int perm32(int rho) { const int n = rho >> 4, i = rho & 15; return 8 * (i >> 2) + 4 * n + (i & 3); }

struct Unit { int pm, pn; };
struct Gemm { const bf16_t* A; const bf16_t* Bt; int M, N, K, apn; };

struct StaticOrder {
    int nM, nN, nwg, G, c;
    __host__ __device__ void init(int M, int N, int G_, int c_) { nM = M / BM; nN = N / BM; nwg = nM * nN; G = G_; c = c_; }
    __host__ __device__ bool next(int i, Unit& u) const {
        const long L = (long)i * G + c; if (L >= nwg) return false;
        int wgid = (int)L; { const int q = nwg / NXCD, r = nwg % NXCD, xcd = wgid % NXCD, off = wgid / NXCD; wgid = (xcd < r ? xcd * (q + 1) : r * (q + 1) + (xcd - r) * q) + off; }
        const int nig = WGM * nN, gid = wgid / nig, fm = gid * WGM, gsz = (nM - fm) < WGM ? (nM - fm) : WGM;
        u.pm = fm + ((wgid % nig) % gsz); u.pn = (wgid % nig) / gsz; return true;
    }
    __device__ __forceinline__ void a_ready(const Unit&) const {}
    __device__ __forceinline__ void done(const Unit&) const {}
};
typedef float f32x2c __attribute__((ext_vector_type(2))); typedef __bf16 bf16x2c __attribute__((ext_vector_type(2)));
__device__ __forceinline__ unsigned cvt_pk_bf16(float lo, float hi) { const f32x2c v = {lo, hi}; return __builtin_bit_cast(unsigned, __builtin_convertvector(v, bf16x2c)); }
typedef unsigned u32x2 __attribute__((ext_vector_type(2)));
__device__ __forceinline__ float silu_e(float x) { return x * __builtin_amdgcn_rcpf(1.0f + __expf(-x)); }
__device__ __forceinline__ float sigm_e(float x) { return __builtin_amdgcn_rcpf(1.0f + __expf(-x)); }
__device__ __forceinline__ u32x4 pack8(const f32x4 v0, const f32x4 v1) { u32x4 w; w.x = cvt_pk_bf16(v0[0], v0[1]); w.y = cvt_pk_bf16(v0[2], v0[3]); w.z = cvt_pk_bf16(v1[0], v1[1]); w.w = cvt_pk_bf16(v1[2], v1[3]); return w; }
__device__ __forceinline__ float bflo(unsigned w) { return __uint_as_float(w << 16); }
__device__ __forceinline__ float bfhi(unsigned w) { return __uint_as_float(w & 0xffff0000u); }

struct EpiIn {
    static constexpr bool PERM = true, AFTER_DRAIN = false;
    bf16_t *Q, *Kb, *KT, *VT, *GR, *U, *G; const float* TRIG;
    template <int SEC> __device__ __forceinline__ void rot(bf16_t* O, const f32x4 (&acc)[2][2][4][2], int t, int rbase, int wc, int fq) const {
        const int head = 2 * t + (wc >> 1), i0 = 32 * (wc & 1) + 8 * fq;
        const float sc = SEC == 0 ? Q_SCALE : 1.0f;
#pragma unroll
        for (int ai = 0; ai < 2; ++ai)
#pragma unroll
            for (int m = 0; m < 4; ++m) {
                const int r = rbase + ai * HALF + m * 16;
                const f32x4* T = (const f32x4*)(TRIG + ((size_t)r * 64 + i0) * 2);
                const f32x4 t0 = T[0], t1 = T[1], t2 = T[2], t3 = T[3];
                const f32x4 xa = acc[ai][0][m][0], xb = acc[ai][0][m][1], ya = acc[ai][1][m][0], yb = acc[ai][1][m][1];
                f32x4 pa, pb, qa, qb;
                pa[0] = (xa[0] * t0[0] - ya[0] * t0[1]) * sc; qa[0] = (ya[0] * t0[0] + xa[0] * t0[1]) * sc;
                pa[1] = (xa[1] * t0[2] - ya[1] * t0[3]) * sc; qa[1] = (ya[1] * t0[2] + xa[1] * t0[3]) * sc;
                pa[2] = (xa[2] * t1[0] - ya[2] * t1[1]) * sc; qa[2] = (ya[2] * t1[0] + xa[2] * t1[1]) * sc;
                pa[3] = (xa[3] * t1[2] - ya[3] * t1[3]) * sc; qa[3] = (ya[3] * t1[2] + xa[3] * t1[3]) * sc;
                pb[0] = (xb[0] * t2[0] - yb[0] * t2[1]) * sc; qb[0] = (yb[0] * t2[0] + xb[0] * t2[1]) * sc;
                pb[1] = (xb[1] * t2[2] - yb[1] * t2[3]) * sc; qb[1] = (yb[1] * t2[2] + xb[1] * t2[3]) * sc;
                pb[2] = (xb[2] * t3[0] - yb[2] * t3[1]) * sc; qb[2] = (yb[2] * t3[0] + xb[2] * t3[1]) * sc;
                pb[3] = (xb[3] * t3[2] - yb[3] * t3[3]) * sc; qb[3] = (yb[3] * t3[2] + xb[3] * t3[3]) * sc;
                const u32x4 w1 = pack8(pa, pb), w2 = pack8(qa, qb);
                bf16_t* rowp = O + (size_t)r * QKW + head * DK + i0;
                *(u32x4*)rowp = w1; *(u32x4*)(rowp + 64) = w2;
                if (SEC == 1) {
                    bf16_t* kt = KT + ((size_t)((r >> 12) * HEADS + head) * DK + i0) * SEQ + (r & (SEQ - 1));
                    kt[(size_t)0 * SEQ] = (bf16_t)(w1.x & 0xffffu); kt[(size_t)1 * SEQ] = (bf16_t)(w1.x >> 16); kt[(size_t)2 * SEQ] = (bf16_t)(w1.y & 0xffffu); kt[(size_t)3 * SEQ] = (bf16_t)(w1.y >> 16);
                    kt[(size_t)4 * SEQ] = (bf16_t)(w1.z & 0xffffu); kt[(size_t)5 * SEQ] = (bf16_t)(w1.z >> 16); kt[(size_t)6 * SEQ] = (bf16_t)(w1.w & 0xffffu); kt[(size_t)7 * SEQ] = (bf16_t)(w1.w >> 16);
                    kt[(size_t)64 * SEQ] = (bf16_t)(w2.x & 0xffffu); kt[(size_t)65 * SEQ] = (bf16_t)(w2.x >> 16); kt[(size_t)66 * SEQ] = (bf16_t)(w2.y & 0xffffu); kt[(size_t)67 * SEQ] = (bf16_t)(w2.y >> 16);
                    kt[(size_t)68 * SEQ] = (bf16_t)(w2.z & 0xffffu); kt[(size_t)69 * SEQ] = (bf16_t)(w2.z >> 16); kt[(size_t)70 * SEQ] = (bf16_t)(w2.w & 0xffffu); kt[(size_t)71 * SEQ] = (bf16_t)(w2.w >> 16);
                }
                asm volatile("" ::: "memory");
            }
    }
    template <int ACT> __device__ __forceinline__ void rows(bf16_t* O, int ldc, int colt, const f32x4 (&acc)[2][2][4][2], int rbase, int cl) const {
#pragma unroll
        for (int ai = 0; ai < 2; ++ai)
#pragma unroll
            for (int m = 0; m < 4; ++m) { bf16_t* rowp = O + (size_t)(rbase + ai * HALF + m * 16) * ldc + colt + cl;
#pragma unroll
                for (int bj = 0; bj < 2; ++bj) { f32x4 v0 = acc[ai][bj][m][0], v1 = acc[ai][bj][m][1];
                    if (ACT == 1) {
#pragma unroll
                        for (int e = 0; e < 4; ++e) { v0[e] = silu_e(v0[e]); v1[e] = silu_e(v1[e]); } }
                    if (ACT == 2) {
#pragma unroll
                        for (int e = 0; e < 4; ++e) { v0[e] = sigm_e(v0[e]); v1[e] = sigm_e(v1[e]); } }
                    *(u32x4*)(rowp + bj * HALF) = pack8(v0, v1); } }
    }
    __device__ __forceinline__ void operator()(const f32x4 (&acc)[2][2][4][2], const Unit& u, int wr, int wc, int fr_, int fq_) const {
        int fr = fr_, fq = fq_; asm volatile("" : "+v"(fr), "+v"(fq));
        const int pn = u.pn, rbase = u.pm * BM + wr * 64 + fr, cl = wc * 32 + 8 * fq;
        if (pn < 4) rot<0>(Q, acc, pn, rbase, wc, fq);
        else if (pn < 8) rot<1>(Kb, acc, pn - 4, rbase, wc, fq);
        else if (pn < 16) {
            const int head = pn - 8;
#pragma unroll
            for (int ai = 0; ai < 2; ++ai)
#pragma unroll
                for (int m = 0; m < 4; ++m) {
                    const int r = rbase + ai * HALF + m * 16;
                    bf16_t* vt = VT + ((size_t)((r >> 12) * HEADS + head) * DV + cl) * SEQ + (r & (SEQ - 1));
#pragma unroll
                    for (int bj = 0; bj < 2; ++bj)
#pragma unroll
                        for (int n = 0; n < 2; ++n) { const f32x4 v = acc[ai][bj][m][n]; const unsigned p0 = cvt_pk_bf16(v[0], v[1]), p1 = cvt_pk_bf16(v[2], v[3]);
                            bf16_t* q = vt + (size_t)(bj * HALF + 4 * n) * SEQ;
                            q[0] = (bf16_t)(p0 & 0xffffu); q[(size_t)SEQ] = (bf16_t)(p0 >> 16); q[(size_t)2 * SEQ] = (bf16_t)(p1 & 0xffffu); q[(size_t)3 * SEQ] = (bf16_t)(p1 >> 16); }
                }
        }
        else if (pn < 24) rows<1>(GR, VW, (pn - 16) * BM, acc, rbase, cl);
        else if (pn < 28) rows<0>(U, PW, (pn - 24) * BM, acc, rbase, cl);
        else rows<2>(G, 2 * D, (pn - 28) * BM, acc, rbase, cl);
    }
};
struct EpiGU {
    static constexpr bool PERM = true, AFTER_DRAIN = false;
    bf16_t* H;
    __device__ __forceinline__ void operator()(const f32x4 (&acc)[2][2][4][2], const Unit& u, int wr, int wc, int fr_, int fq_) const {
        int fr = fr_, fq = fq_; asm volatile("" : "+v"(fr), "+v"(fq));
        const int rbase = u.pm * BM + wr * 64 + fr, col = u.pn * HALF + wc * 32 + 8 * fq;
#pragma unroll
        for (int ai = 0; ai < 2; ++ai)
#pragma unroll
            for (int m = 0; m < 4; ++m) { f32x4 v0 = acc[ai][0][m][0], v1 = acc[ai][0][m][1]; const f32x4 u0 = acc[ai][1][m][0], u1 = acc[ai][1][m][1];
#pragma unroll
                for (int e = 0; e < 4; ++e) { v0[e] = silu_e(v0[e]) * u0[e]; v1[e] = silu_e(v1[e]) * u1[e]; }
                *(u32x4*)(H + (size_t)(rbase + ai * HALF + m * 16) * DFF + col) = pack8(v0, v1); }
    }
};
struct EpiResid {
    static constexpr bool PERM = false, AFTER_DRAIN = false;
    const float* base; float* out;
    __device__ __forceinline__ void operator()(const f32x4 (&acc)[2][2][4][2], const Unit& u, int wr, int wc, int fr_, int fq_) const {
        int fr = fr_, fq = fq_; asm volatile("" : "+v"(fr), "+v"(fq));
        const int row0 = u.pm * BM + wr * 64 + fr, col0 = u.pn * BM + wc * 32 + 4 * fq;
#pragma unroll
        for (int ai = 0; ai < 2; ++ai)
#pragma unroll
            for (int m = 0; m < 4; ++m) { const size_t off = (size_t)(row0 + ai * HALF + m * 16) * D + col0;
#pragma unroll
                for (int bj = 0; bj < 2; ++bj)
#pragma unroll
                    for (int n = 0; n < 2; ++n) { const f32x4 b = *(const f32x4*)(base + off + bj * HALF + n * 16); *(f32x4*)(out + off + bj * HALF + n * 16) = b + acc[ai][bj][m][n]; } }
    }
};
struct EpiT1 {
    static constexpr bool PERM = true, AFTER_DRAIN = false;
    const bf16_t* G; bf16_t* T1;
    __device__ __forceinline__ void operator()(const f32x4 (&acc)[2][2][4][2], const Unit& u, int wr, int wc, int fr_, int fq_) const {
        int fr = fr_, fq = fq_; asm volatile("" : "+v"(fr), "+v"(fq));
        const int rbase = u.pm * BM + wr * 64 + fr, col = u.pn * BM + wc * 32 + 8 * fq;
#pragma unroll
        for (int ai = 0; ai < 2; ++ai)
#pragma unroll
            for (int m = 0; m < 4; ++m) { const int r = rbase + ai * HALF + m * 16;
#pragma unroll
                for (int bj = 0; bj < 2; ++bj) { const u32x4 g = *(const u32x4*)(G + (size_t)r * (2 * D) + col + bj * HALF);
                    const f32x4 g0 = {bflo(g.x), bfhi(g.x), bflo(g.y), bfhi(g.y)}, g1 = {bflo(g.z), bfhi(g.z), bflo(g.w), bfhi(g.w)};
                    *(u32x4*)(T1 + (size_t)r * D + col + bj * HALF) = pack8(g0 * acc[ai][bj][m][0], g1 * acc[ai][bj][m][1]); } }
    }
};
struct EpiMG {
    static constexpr bool PERM = true, AFTER_DRAIN = false;
    const bf16_t* G; const bf16_t* T1; bf16_t* MG;
    __device__ __forceinline__ void operator()(const f32x4 (&acc)[2][2][4][2], const Unit& u, int wr, int wc, int fr_, int fq_) const {
        int fr = fr_, fq = fq_; asm volatile("" : "+v"(fr), "+v"(fq));
        const int rbase = u.pm * BM + wr * 64 + fr, col = u.pn * BM + wc * 32 + 8 * fq;
#pragma unroll
        for (int ai = 0; ai < 2; ++ai)
#pragma unroll
            for (int m = 0; m < 4; ++m) { const int r = rbase + ai * HALF + m * 16;
#pragma unroll
                for (int bj = 0; bj < 2; ++bj) { const u32x4 g = *(const u32x4*)(G + (size_t)r * (2 * D) + D + col + bj * HALF), t = *(const u32x4*)(T1 + (size_t)r * D + col + bj * HALF);
                    const f32x4 g0 = {bflo(g.x), bfhi(g.x), bflo(g.y), bfhi(g.y)}, g1 = {bflo(g.z), bfhi(g.z), bflo(g.w), bfhi(g.w)};
                    const f32x4 t0 = {bflo(t.x), bfhi(t.x), bflo(t.y), bfhi(t.y)}, t1 = {bflo(t.z), bfhi(t.z), bflo(t.w), bfhi(t.w)};
                    *(u32x4*)(MG + (size_t)r * D + col + bj * HALF) = pack8(t0 + g0 * acc[ai][bj][m][0], t1 + g1 * acc[ai][bj][m][1]); } }
    }
};
struct EpiPlain {
    static constexpr bool PERM = true, AFTER_DRAIN = false;
    bf16_t* O; int ldc;
    __device__ __forceinline__ void operator()(const f32x4 (&acc)[2][2][4][2], const Unit& u, int wr, int wc, int fr_, int fq_) const {
        int fr = fr_, fq = fq_; asm volatile("" : "+v"(fr), "+v"(fq));
        const int rbase = u.pm * BM + wr * 64 + fr, col = u.pn * BM + wc * 32 + 8 * fq;
#pragma unroll
        for (int ai = 0; ai < 2; ++ai)
#pragma unroll
            for (int m = 0; m < 4; ++m)
#pragma unroll
                for (int bj = 0; bj < 2; ++bj) *(u32x4*)(O + (size_t)(rbase + ai * HALF + m * 16) * ldc + col + bj * HALF) = pack8(acc[ai][bj][m][0], acc[ai][bj][m][1]);
    }
};
template <class Epi, class Sched, bool ALIGN_EPI = false, bool SP2 = false>
__device__ __forceinline__ void gemm_phase(PG8_LAS unsigned char* lds, const Gemm g, const Sched& S, const Epi& E) {
    int tid_ = threadIdx.x; asm volatile("" : "+v"(tid_));
    const int tid = tid_, wid = __builtin_amdgcn_readfirstlane(tid >> 6), lane = tid & 63, wr = wid >> 2, wc = wid & 3, fr = lane & 15, fq = lane >> 4;
    const int K = g.K, nt = K / BK;
    unsigned voffA[2], voffB[2];
#pragma unroll
    for (int i = 0; i < 2; ++i) { int R, C; stage_rc(tid * 16 + i * 8192, R, C); const int Rb = Epi::PERM ? ((R & ~31) + perm32(R & 31)) : R;
        voffA[i] = (unsigned)(R * K + C) * 2u; voffB[i] = (unsigned)(Rb * K + C) * 2u; }
    const size_t kstep = (size_t)(BK * 2);
    const size_t hstep = (size_t)HALF * K * 2;
    const size_t tstep = 2 * hstep;
    const unsigned ldsw = (unsigned)wid * 1024u;
    const int aoff = lds_byte(wr * 64 + fr, fq * 8), boff = lds_byte(wc * 32 + fr, fq * 8);
#define PG8_SA(b, h) (((b) * 2 + (h)) * HTB)
#define PG8_SB(b, h) ((4 + (b) * 2 + (h)) * HTB)
#define PG8_STAGE(bufoff, gbase, voff) do { _Pragma("unroll") for (int _i = 0; _i < 2; ++_i) \
        __builtin_amdgcn_global_load_lds((const unsigned*)((const char*)(gbase) + (voff)[_i]), (PG8_LAS unsigned*)(lds + (bufoff) + ldsw + _i * 8192), 16, 0, 0); } while (0)
#define PG8_LDA(dst, b, h) do { _Pragma("unroll") for (int m = 0; m < 4; ++m) _Pragma("unroll") for (int k = 0; k < 2; ++k) dst[m][k] = *(const PG8_LAS bf16x8*)(lds + PG8_SA(b, h) + aoff + m * 2048 + k * 1024); } while (0)
#define PG8_LDB(dst, b, h) do { _Pragma("unroll") for (int n = 0; n < 2; ++n) _Pragma("unroll") for (int k = 0; k < 2; ++k) dst[n][k] = *(const PG8_LAS bf16x8*)(lds + PG8_SB(b, h) + boff + n * 2048 + k * 1024); } while (0)
#define PG8_MMA(ai, bj, At, Bt) do { __builtin_amdgcn_s_setprio(1); _Pragma("unroll") for (int m = 0; m < 4; ++m) _Pragma("unroll") for (int n = 0; n < 2; ++n) _Pragma("unroll") for (int k = 0; k < 2; ++k) \
        acc[ai][bj][m][n] = __builtin_amdgcn_mfma_f32_16x16x32_bf16(Bt[n][k], At[m][k], acc[ai][bj][m][n], 0, 0, 0); __builtin_amdgcn_s_setprio(0); } while (0)
#define PG8_WAIT_V(n) asm volatile("s_waitcnt vmcnt(" #n ")" ::: "memory")
#define PG8_WAIT_L(n) asm volatile("s_waitcnt lgkmcnt(" #n ")" ::: "memory")
#define PG8_BAR __builtin_amdgcn_s_barrier()
#define PG8_SCHED __builtin_amdgcn_sched_barrier(0)
    Unit cur, nxt; int ui = 0;
    if (!S.next(0, cur)) return;
    f32x4 acc[2][2][4][2];
#pragma unroll
    for (int a = 0; a < 2; ++a)
#pragma unroll
        for (int b = 0; b < 2; ++b)
#pragma unroll
            for (int m = 0; m < 4; ++m)
#pragma unroll
                for (int n = 0; n < 2; ++n) acc[a][b][m][n] = (f32x4){0.f, 0.f, 0.f, 0.f};
    bf16x8 At[4][2], B0[2][2], B1[2][2];
    const char* cA = (const char*)g.A + (size_t)(cur.pm + cur.pn * g.apn) * tstep; const char* cB = (const char*)g.Bt + (size_t)cur.pn * tstep;
    S.a_ready(cur);
    if constexpr (SP2) {
        PG8_STAGE(PG8_SB(0, 0), cB, voffB); PG8_STAGE(PG8_SB(0, 1), cB + hstep, voffB); PG8_STAGE(PG8_SA(0, 0), cA, voffA); PG8_STAGE(PG8_SA(0, 1), cA + hstep, voffA);
        if (wr == 1) PG8_BAR;
        PG8_WAIT_V(2); PG8_BAR;
        PG8_STAGE(PG8_SB(1, 0), cB + kstep, voffB); PG8_STAGE(PG8_SA(1, 0), cA + kstep, voffA); PG8_STAGE(PG8_SB(1, 1), cB + hstep + kstep, voffB);
        PG8_WAIT_V(6); PG8_BAR;
    } else {
        PG8_STAGE(PG8_SB(0, 0), cB, voffB); PG8_STAGE(PG8_SA(0, 0), cA, voffA); PG8_STAGE(PG8_SB(0, 1), cB + hstep, voffB); PG8_STAGE(PG8_SA(0, 1), cA + hstep, voffA);
        if (wr == 1) PG8_BAR;
        PG8_WAIT_V(4); PG8_BAR;
        PG8_STAGE(PG8_SB(1, 0), cB + kstep, voffB); PG8_STAGE(PG8_SA(1, 0), cA + kstep, voffA); PG8_STAGE(PG8_SB(1, 1), cB + hstep + kstep, voffB);
        PG8_WAIT_V(6); PG8_BAR;
    }
    for (;;) {
        const bool has_next = S.next(ui + 1, nxt);
        const char* nA = has_next ? (const char*)g.A + (size_t)(nxt.pm + nxt.pn * g.apn) * tstep : cA; const char* nB = has_next ? (const char*)g.Bt + (size_t)nxt.pn * tstep : cB;
_Pragma("unroll 1")
        for (int t = 0; t < nt; t += 2) {
            const bool last = (t == nt - 2);
            const char* a1 = cA + (size_t)(t + 1) * kstep;
            const char* a2 = last ? nA : cA + (size_t)(t + 2) * kstep; const char* b2 = last ? nB : cB + (size_t)(t + 2) * kstep;
            const char* a3 = a2 + kstep; const char* b3 = b2 + kstep;
            if (last && has_next) S.a_ready(nxt);
            if constexpr (SP2) {
            PG8_LDB(B0, 0, 0); PG8_LDB(B1, 0, 1); PG8_SCHED; PG8_LDA(At, 0, 0); PG8_STAGE(PG8_SA(1, 1), a1 + hstep, voffA);
            PG8_WAIT_V(8); PG8_WAIT_L(0); PG8_BAR; PG8_MMA(0, 0, At, B0); PG8_MMA(0, 1, At, B1); PG8_BAR; PG8_SCHED;
            PG8_LDA(At, 0, 1); PG8_STAGE(PG8_SB(0, 0), b2, voffB); PG8_STAGE(PG8_SB(0, 1), b2 + hstep, voffB); PG8_STAGE(PG8_SA(0, 0), a2, voffA);
            PG8_WAIT_V(8); PG8_WAIT_L(0); PG8_BAR; PG8_MMA(1, 0, At, B0); PG8_MMA(1, 1, At, B1); PG8_BAR; PG8_SCHED;
            PG8_LDB(B0, 1, 0); PG8_LDB(B1, 1, 1); PG8_SCHED; PG8_LDA(At, 1, 0); PG8_STAGE(PG8_SA(0, 1), a2 + hstep, voffA);
            PG8_WAIT_V(8); PG8_WAIT_L(0); PG8_BAR; PG8_MMA(0, 0, At, B0); PG8_MMA(0, 1, At, B1); PG8_BAR; PG8_SCHED;
            PG8_LDA(At, 1, 1); PG8_STAGE(PG8_SB(1, 0), b3, voffB); PG8_STAGE(PG8_SB(1, 1), b3 + hstep, voffB); PG8_STAGE(PG8_SA(1, 0), a3, voffA);
            PG8_WAIT_V(8); PG8_WAIT_L(0); PG8_BAR; PG8_MMA(1, 0, At, B0); PG8_MMA(1, 1, At, B1); PG8_BAR; PG8_SCHED;
            } else {
            PG8_LDB(B0, 0, 0); PG8_SCHED; PG8_LDA(At, 0, 0); PG8_STAGE(PG8_SA(1, 1), a1 + hstep, voffA);
            PG8_WAIT_L(8); PG8_BAR; PG8_WAIT_L(0); PG8_MMA(0, 0, At, B0); PG8_BAR; PG8_SCHED;
            PG8_LDB(B1, 0, 1); PG8_STAGE(PG8_SB(0, 0), b2, voffB);
            PG8_BAR; PG8_WAIT_L(0); PG8_MMA(0, 1, At, B1); PG8_BAR;
            PG8_LDA(At, 0, 1); PG8_STAGE(PG8_SA(0, 0), a2, voffA);
            PG8_BAR; PG8_WAIT_L(0); PG8_MMA(1, 0, At, B0); PG8_BAR; PG8_SCHED;
            PG8_STAGE(PG8_SB(0, 1), b2 + hstep, voffB);
            PG8_WAIT_V(6); PG8_BAR; PG8_MMA(1, 1, At, B1); PG8_BAR;
            PG8_LDB(B0, 1, 0); PG8_SCHED; PG8_LDA(At, 1, 0); PG8_STAGE(PG8_SA(0, 1), a2 + hstep, voffA);
            PG8_WAIT_L(8); PG8_BAR; PG8_WAIT_L(0); PG8_MMA(0, 0, At, B0); PG8_BAR; PG8_SCHED;
            PG8_LDB(B1, 1, 1); PG8_STAGE(PG8_SB(1, 0), b3, voffB);
            PG8_BAR; PG8_WAIT_L(0); PG8_MMA(0, 1, At, B1); PG8_BAR;
            PG8_LDA(At, 1, 1); PG8_STAGE(PG8_SA(1, 0), a3, voffA);
            PG8_BAR; PG8_WAIT_L(0); PG8_MMA(1, 0, At, B0); PG8_BAR; PG8_SCHED;
            PG8_STAGE(PG8_SB(1, 1), b3 + hstep, voffB);
            PG8_WAIT_V(6); PG8_BAR; PG8_MMA(1, 1, At, B1); PG8_BAR;
            }
        }
        if constexpr (ALIGN_EPI) { if (wr == 0) PG8_BAR; }
        if constexpr (!Epi::AFTER_DRAIN) { E(acc, cur, wr, wc, fr, fq); S.done(cur); }
        if (!has_next) break;
#pragma unroll
        for (int a = 0; a < 2; ++a)
#pragma unroll
            for (int b = 0; b < 2; ++b)
#pragma unroll
                for (int m = 0; m < 4; ++m)
#pragma unroll
                    for (int n = 0; n < 2; ++n) acc[a][b][m][n] = (f32x4){0.f, 0.f, 0.f, 0.f};
        cur = nxt; cA = nA; cB = nB; ++ui;
        if constexpr (ALIGN_EPI) { if (wr == 1) PG8_BAR; }
    }
    PG8_WAIT_V(0);
    if constexpr (!ALIGN_EPI) { if (wr == 0) PG8_BAR; }
    PG8_BAR;
    if constexpr (Epi::AFTER_DRAIN) { E.fused(acc, cur, wr, wc, fr, fq, lds, wid, lane); S.done(cur); }
#undef PG8_SA
#undef PG8_SB
#undef PG8_STAGE
#undef PG8_LDA
#undef PG8_LDB
#undef PG8_MMA
#undef PG8_WAIT_V
#undef PG8_WAIT_L
#undef PG8_BAR
#undef PG8_SCHED
}
}
#define XB_TMO      128
#define XB_XCNT(j)  (256  + 64 * (j))
#define XB_XSUB(j)  (1280 + 64 * (j))
#define XB_XGEN(j)  (2304 + 64 * (j))
#define XB_TOP      3328
#define XB_TOPGEN   3392
#define XCD_BAR_WORDS 3456
#define XB_SPIN_CAP (1u << 18)

__device__ __forceinline__ unsigned xb_ld(unsigned* p)              { return __hip_atomic_load(p, __ATOMIC_RELAXED, __HIP_MEMORY_SCOPE_AGENT); }
__device__ __forceinline__ unsigned xb_add(unsigned* p, unsigned v) { return __hip_atomic_fetch_add(p, v, __ATOMIC_RELAXED, __HIP_MEMORY_SCOPE_AGENT); }
__device__ __forceinline__ unsigned xb_xcc_id() { return (unsigned)__builtin_amdgcn_s_getreg((3 << 11) | 20) & 0xFu; }
#define XB_SPIN(cond, bar) do { unsigned _sp = 0; while (cond) { __builtin_amdgcn_s_sleep(1); \
    if ((++_sp & 255u) == 0u) { if (xb_ld(&(bar)[XB_TMO])) break; if (_sp > XB_SPIN_CAP) { atomicAdd(&(bar)[XB_TMO], 1u); break; } } } } while (0)

struct XcdBarrier {
    unsigned* bar; unsigned x;
    volatile LAS unsigned* st;
};

__device__ __forceinline__ XcdBarrier xcd_barrier_post(unsigned* bar, volatile LAS unsigned* st) {
    XcdBarrier b; b.bar = bar; b.x = xb_xcc_id(); b.st = st;
    if (threadIdx.x == 0) (void)xb_add(&bar[XB_XCNT(b.x)], 1u);
    return b;
}
__device__ __forceinline__ void xcd_barrier_complete(unsigned* bar, unsigned x, unsigned& nloc, unsigned& nx) {
    const unsigned G = gridDim.x * gridDim.y * gridDim.z;
    unsigned sum, cnt, mine, sp = 0u;
    for (;;) {
        sum = 0u; cnt = 0u; mine = 0u;
#pragma unroll
        for (unsigned j = 0; j < 16; ++j) { const unsigned c = xb_ld(&bar[XB_XCNT(j)]); sum += c; cnt += (c > 0u) ? 1u : 0u; mine = (j == x) ? c : mine; }
        if (sum == G) break;
        __builtin_amdgcn_s_sleep(1);
        if ((++sp & 255u) == 0u) { if (xb_ld(&bar[XB_TMO])) break; if (sp > XB_SPIN_CAP) { atomicAdd(&bar[XB_TMO], 1u); break; } }
    }
    nloc = mine > 0u ? mine : 1u; nx = cnt > 0u ? cnt : 1u;
}

__device__ __forceinline__ void xcd_barrier(const XcdBarrier& b) {
    asm volatile("s_waitcnt vmcnt(0)" ::: "memory");
    __syncthreads();
    if (threadIdx.x == 0) {
        unsigned* bar = b.bar;
        __builtin_amdgcn_s_waitcnt(0);
        unsigned nloc = b.st[0], nx = b.st[1];
        if (nloc == 0u) { xcd_barrier_complete(bar, b.x, nloc, nx); b.st[0] = nloc; b.st[1] = nx; }
        const unsigned old = xb_add(&bar[XB_XSUB(b.x)], 1u);
        const unsigned gen = old / nloc;
        if (old + 1u == (gen + 1u) * nloc) {
            __builtin_amdgcn_fence(__ATOMIC_RELEASE, "agent");
            asm volatile("s_waitcnt vmcnt(0)" ::: "memory");
            const unsigned og = xb_add(&bar[XB_TOP], 1u);
            const unsigned tg = og / nx;
            if (og + 1u == (tg + 1u) * nx) xb_add(&bar[XB_TOPGEN], 1u);
            else XB_SPIN(xb_ld(&bar[XB_TOPGEN]) == tg, bar);
            __builtin_amdgcn_fence(__ATOMIC_ACQUIRE, "agent");
            xb_add(&bar[XB_XGEN(b.x)], 1u);
            asm volatile("s_waitcnt vmcnt(0)" ::: "memory");
        } else {
            XB_SPIN(xb_ld(&bar[XB_XGEN(b.x)]) == gen, bar);
            __builtin_amdgcn_fence(__ATOMIC_ACQUIRE, "agent");
            asm volatile("s_waitcnt vmcnt(0)" ::: "memory");
        }
    }
    __syncthreads();
}
using pg8::cvt_pk_bf16;
__device__ __forceinline__ float bflo(unsigned w) { return __uint_as_float(w << 16); }
__device__ __forceinline__ float bfhi(unsigned w) { return __uint_as_float(w & 0xffff0000u); }
__device__ __forceinline__ bf16x8 scale_frag8(const bf16x8 v, const float (&z)[8]) {
    const u32x4 w = __builtin_bit_cast(u32x4, v); u32x4 o;
    o.x = cvt_pk_bf16(bflo(w.x) * z[0], bfhi(w.x) * z[1]); o.y = cvt_pk_bf16(bflo(w.y) * z[2], bfhi(w.y) * z[3]);
    o.z = cvt_pk_bf16(bflo(w.z) * z[4], bfhi(w.z) * z[5]); o.w = cvt_pk_bf16(bflo(w.w) * z[6], bfhi(w.w) * z[7]);
    return __builtin_bit_cast(bf16x8, o);
}
__device__ __forceinline__ bf16x8 scale_frag1(const bf16x8 v, const float z) {
    const u32x4 w = __builtin_bit_cast(u32x4, v); u32x4 o;
    o.x = cvt_pk_bf16(bflo(w.x) * z, bfhi(w.x) * z); o.y = cvt_pk_bf16(bflo(w.y) * z, bfhi(w.y) * z);
    o.z = cvt_pk_bf16(bflo(w.z) * z, bfhi(w.z) * z); o.w = cvt_pk_bf16(bflo(w.w) * z, bfhi(w.w) * z);
    return __builtin_bit_cast(bf16x8, o);
}

#define BAR_LDS() do { asm volatile("s_waitcnt lgkmcnt(0)" ::: "memory"); __builtin_amdgcn_s_barrier(); asm volatile("" ::: "memory"); } while (0)
constexpr int KS = 288, VS = 272;
__device__ __forceinline__ void ld_tile4(u32x4 (&r)[4], const bf16_t* src, size_t row_elems, int tid) {
#pragma unroll
    for (int i = 0; i < 4; ++i) { const int p = tid + 512 * i; r[i] = *(const u32x4*)(src + (size_t)(p >> 4) * row_elems + (p & 15) * 8); }
}
__device__ __forceinline__ void st_tile4(LAS unsigned char* dst, int stride, const u32x4 (&r)[4], int tid) {
#pragma unroll
    for (int i = 0; i < 4; ++i) { const int p = tid + 512 * i; *(LAS u32x4*)(dst + (p >> 4) * stride + (p & 15) * 16) = r[i]; }
}

constexpr int SCAN_BUF = 128 * KS + 16 * KS;
__device__ __forceinline__ void scan_cu(LAS unsigned char* L, const bf16_t* KT, const bf16_t* VT, bf16_t* ST, int unit, int w, int lane, int tid) {
    const int bh = unit >> 4, dvs = unit & 15, h = bh & 7, fr = lane & 15, fq = lane >> 4;
    const float lg = log2f(1.0f - exp2f(-5.0f - (float)h));
    const float decay = exp2f(128.0f * lg);
    float z[4][8];
#pragma unroll
    for (int ks = 0; ks < 4; ++ks)
#pragma unroll
        for (int j = 0; j < 8; ++j) z[ks][j] = exp2f((float)(127 - (32 * ks + 8 * fq + j)) * lg);
    const bf16_t* ksrc = KT + (size_t)(bh * DK) * SEQ;
    const bf16_t* vsrc = VT + ((size_t)(bh * DV + dvs * 16) + (tid >> 4)) * SEQ + (tid & 15) * 8;
    bf16_t* st = ST + ((size_t)bh * NCH * DV + dvs * 16 + fr) * DK + 16 * w + 4 * fq;
    const bool vth = tid < 256;
    u32x4 qk[4][4], qv[4];
#pragma unroll
    for (int s = 0; s < 4; ++s) { ld_tile4(qk[s], ksrc + s * CHUNK, SEQ, tid); qv[s] = (u32x4){0u, 0u, 0u, 0u}; if (vth) qv[s] = *(const u32x4*)(vsrc + s * CHUNK); }
    f32x4 S = {0.f, 0.f, 0.f, 0.f};
#pragma unroll 1
    for (int n4 = 0; n4 < NCH; n4 += 4) {
#pragma unroll
        for (int s = 0; s < 4; ++s) {
            const int n = n4 + s;
            LAS unsigned char* buf = L + (s & 1) * SCAN_BUF;
            if (n < NCH - 1) {
                st_tile4(buf, KS, qk[s], tid);
                if (vth) *(LAS u32x4*)(buf + 128 * KS + (tid >> 4) * KS + (tid & 15) * 16) = qv[s];
                if (n + 4 < NCH - 1) { ld_tile4(qk[s], ksrc + (n + 4) * CHUNK, SEQ, tid); if (vth) qv[s] = *(const u32x4*)(vsrc + (n + 4) * CHUNK); }
                BAR_LDS();
            }
            u32x2 wv; wv.x = cvt_pk_bf16(S[0], S[1]); wv.y = cvt_pk_bf16(S[2], S[3]);
            *(u32x2*)(st + (size_t)n * DV * DK) = wv;
            if (n < NCH - 1) {
                f32x4 kv = {0.f, 0.f, 0.f, 0.f};
#pragma unroll
                for (int ks = 0; ks < 4; ++ks) { const bf16x8 a = *(const LAS bf16x8*)(buf + (16 * w + fr) * KS + 64 * ks + 16 * fq), b = *(const LAS bf16x8*)(buf + 128 * KS + fr * KS + 64 * ks + 16 * fq);
                    kv = __builtin_amdgcn_mfma_f32_16x16x32_bf16(a, scale_frag8(b, z[ks]), kv, 0, 0, 0); }
                S = S * decay + kv;
            }
        }
    }
    BAR_LDS();
}

__device__ __forceinline__ void acc8(float (&s)[8], const u32x4 v, const float sg) {
    s[0] += sg * bflo(v.x); s[1] += sg * bfhi(v.x); s[2] += sg * bflo(v.y); s[3] += sg * bfhi(v.y); s[4] += sg * bflo(v.z); s[5] += sg * bfhi(v.z); s[6] += sg * bflo(v.w); s[7] += sg * bfhi(v.w); }
template <int W> __device__ __forceinline__ void pooled_item(const bf16_t* U, bf16_t* PO, int g, int run, int lane) {
    const int sub = lane >> 5, oct = lane & 31, t0 = run * 16 + sub * 8, tb0 = t0 & (SEQ - 1);
    const bf16_t* up = U + (size_t)t0 * PW + g * PGD + oct * 8;
    u32x4 u[W + 7];
#pragma unroll
    for (int i = 0; i < W + 7; ++i) { const int d = i - (W - 1); u[i] = (u32x4){0u, 0u, 0u, 0u}; if (tb0 + d >= 0) u[i] = *(const u32x4*)(up + (ptrdiff_t)d * PW); }
    float sum[8];
#pragma unroll
    for (int e = 0; e < 8; ++e) sum[e] = 0.f;
#pragma unroll
    for (int i = 0; i < W - 1; ++i) acc8(sum, u[i], 1.0f);
    bf16_t* po = PO + ((size_t)g * M + t0) * PGD + oct * 8;
#pragma unroll
    for (int o = 0; o < 8; ++o) {
        const u32x4 cu = u[W - 1 + o];
        acc8(sum, cu, 1.0f);
        if (o >= 1) acc8(sum, u[o - 1], -1.0f);
        const float cnt = (float)((tb0 + o + 1 < W) ? tb0 + o + 1 : W);
        u32x4 w; w.x = cvt_pk_bf16(sum[0] / cnt - bflo(cu.x), sum[1] / cnt - bfhi(cu.x)); w.y = cvt_pk_bf16(sum[2] / cnt - bflo(cu.y), sum[3] / cnt - bfhi(cu.y));
        w.z = cvt_pk_bf16(sum[4] / cnt - bflo(cu.z), sum[5] / cnt - bfhi(cu.z)); w.w = cvt_pk_bf16(sum[6] / cnt - bflo(cu.w), sum[7] / cnt - bfhi(cu.w));
        *(u32x4*)(po + (size_t)o * PGD) = w;
    }
}

template <int HALF_> __device__ __forceinline__ void retout_half(f32x4 (&acc)[16], const LAS unsigned char* LV, const LAS unsigned char* LS, const unsigned (&pk)[8][2], const bf16x8 (&qx)[4], int w, int fr, int fq) {
#pragma unroll
    for (int kk = 0; kk < 4; ++kk) if (2 * kk <= w) {
        u32x4 bw; bw.x = pk[2 * kk][0]; bw.y = pk[2 * kk][1]; bw.z = pk[2 * kk + 1][0]; bw.w = pk[2 * kk + 1][1];
        const bf16x8 bfrag = __builtin_bit_cast(bf16x8, bw);
#pragma unroll
        for (int d = 0; d < 8; ++d) { const LAS unsigned char* p = LV + (16 * d + fr) * VS + 64 * kk + 8 * fq;
            const u32x2 lo = *(const LAS u32x2*)p, hi = *(const LAS u32x2*)(p + 32);
            u32x4 aw; aw.x = lo.x; aw.y = lo.y; aw.z = hi.x; aw.w = hi.y;
            acc[8 * HALF_ + d] = __builtin_amdgcn_mfma_f32_16x16x32_bf16(__builtin_bit_cast(bf16x8, aw), bfrag, acc[8 * HALF_ + d], 0, 0, 0); }
    }
#pragma unroll
    for (int ks = 0; ks < 4; ++ks)
#pragma unroll
        for (int d = 0; d < 8; ++d) acc[8 * HALF_ + d] = __builtin_amdgcn_mfma_f32_16x16x32_bf16(*(const LAS bf16x8*)(LS + (16 * d + fr) * KS + 64 * ks + 16 * fq), qx[ks], acc[8 * HALF_ + d], 0, 0, 0);
}
__device__ __forceinline__ void retout_cu(LAS unsigned char* L, const bf16_t* Q, const bf16_t* Kb, const bf16_t* VT, const bf16_t* ST, const bf16_t* GR, bf16_t* YR, int vcu, int G, int w, int lane, int tid) {
    LAS unsigned char* LK = L; LAS unsigned char* LV = L + 128 * KS; LAS unsigned char* LS = LV + 128 * VS;
    const int fr = lane & 15, fq = lane >> 4, c = 16 * w + fr;
#pragma unroll 1
    for (int unit = vcu; unit < NB * HEADS * NCH; unit += G) {
        const int bh = unit >> 5, n = unit & 31, b = bh >> 3, h = bh & 7;
        const float lg = log2f(1.0f - exp2f(-5.0f - (float)h));
        const int tok0 = b * SEQ + n * CHUNK, s0 = n * CHUNK;
        const bf16_t* vsrc = VT + (size_t)(bh * DV) * SEQ + s0; const bf16_t* ssrc = ST + (size_t)(bh * NCH + n) * DV * DK;
        u32x4 rk[4], rv[4], rs[4];
        ld_tile4(rk, Kb + (size_t)tok0 * QKW + h * DK, QKW, tid); ld_tile4(rv, vsrc, SEQ, tid); ld_tile4(rs, ssrc, DK, tid);
        bf16x8 qf[4];
        { const bf16_t* qp = Q + (size_t)(tok0 + c) * QKW + h * DK + 8 * fq;
#pragma unroll
          for (int ks = 0; ks < 4; ++ks) qf[ks] = *(const bf16x8*)(qp + 32 * ks); }
        st_tile4(LK, KS, rk, tid); st_tile4(LV, VS, rv, tid); st_tile4(LS, KS, rs, tid);
        BAR_LDS();
        ld_tile4(rv, vsrc + (size_t)128 * SEQ, SEQ, tid); ld_tile4(rs, ssrc + 128 * DK, DK, tid);
        unsigned pk[8][2];
#pragma unroll
        for (int mb = 0; mb < 8; ++mb) { pk[mb][0] = 0u; pk[mb][1] = 0u; }
#pragma unroll
        for (int mb = 0; mb < 8; ++mb) if (mb <= w) {
            f32x4 s = {0.f, 0.f, 0.f, 0.f};
#pragma unroll
            for (int ks = 0; ks < 4; ++ks) s = __builtin_amdgcn_mfma_f32_16x16x32_bf16(*(const LAS bf16x8*)(LK + (16 * mb + fr) * KS + 64 * ks + 16 * fq), qf[ks], s, 0, 0, 0);
            float p[4];
#pragma unroll
            for (int r = 0; r < 4; ++r) { const int e = c - (16 * mb + 4 * fq + r); p[r] = e >= 0 ? s[r] * exp2f((float)e * lg) : 0.f; }
            pk[mb][0] = cvt_pk_bf16(p[0], p[1]); pk[mb][1] = cvt_pk_bf16(p[2], p[3]);
        }
        const float xi = exp2f((float)(c + 1) * lg);
        bf16x8 qx[4];
#pragma unroll
        for (int ks = 0; ks < 4; ++ks) qx[ks] = scale_frag1(qf[ks], xi);
        f32x4 acc[16];
#pragma unroll
        for (int d = 0; d < 16; ++d) acc[d] = (f32x4){0.f, 0.f, 0.f, 0.f};
        retout_half<0>(acc, LV, LS, pk, qx, w, fr, fq);
        BAR_LDS();
        st_tile4(LV, VS, rv, tid); st_tile4(LS, KS, rs, tid);
        BAR_LDS();
        retout_half<1>(acc, LV, LS, pk, qx, w, fr, fq);
        float ss = 0.f;
#pragma unroll
        for (int d = 0; d < 16; ++d) ss += (acc[d][0] * acc[d][0] + acc[d][1] * acc[d][1]) + (acc[d][2] * acc[d][2] + acc[d][3] * acc[d][3]);
        ss += __shfl_xor(ss, 16); ss += __shfl_xor(ss, 32);
        const float rinv = rsqrtf(ss * (1.0f / DV) + NORM_EPS);
        const size_t ob = (size_t)(tok0 + c) * VW + h * DV + 4 * fq;
#pragma unroll
        for (int d = 0; d < 16; ++d) { const u32x2 g = *(const u32x2*)(GR + ob + 16 * d);
            u32x2 o; o.x = cvt_pk_bf16(acc[d][0] * rinv * bflo(g.x), acc[d][1] * rinv * bfhi(g.x)); o.y = cvt_pk_bf16(acc[d][2] * rinv * bflo(g.y), acc[d][3] * rinv * bfhi(g.y));
            *(u32x2*)(YR + ob + 16 * d) = o; }
        BAR_LDS();
    }
}

constexpr int NWAVES = 8, RING_BYTES = 131072, LDS_BYTES = 147456, MISC_OFF = LDS_BYTES - 256;
static_assert(NWAVES * TR_SCR_BYTES <= MISC_OFF, "prologue scratch below the control words");
constexpr int NPH_L = 9, NPHASES = 1 + DEPTH * NPH_L;
struct Args { const float* in[13]; float* out; unsigned char* ws; int ph_lo, ph_hi, li, pad; };

__global__ void __launch_bounds__(NWAVES * 64, 2) fwd(Args args) {
    extern __shared__ __attribute__((aligned(16))) unsigned char lds[];
    LAS unsigned char* L = (LAS unsigned char*)lds;
    const int tid = threadIdx.x, lane = tid & 63, wave = __builtin_amdgcn_readfirstlane(tid >> 6);
    const int G = gridDim.x, bx = blockIdx.x, vcu = (G % 8 == 0) ? (bx % 8) * (G / 8) + bx / 8 : bx;
    const int gw = vcu * NWAVES + wave, NGW = G * NWAVES;
    for (int u = tid; u < (LDS_BYTES - RING_BYTES) / 4; u += NWAVES * 64) ((LAS unsigned*)(L + RING_BYTES))[u] = 0u;
    __syncthreads();
    const int lo = args.ph_lo, hi = args.ph_hi;
    unsigned char* const ws0 = args.ws;
    unsigned* barw = (unsigned*)(ws0 + WS_CTL) + CW_BAR + args.li * XCD_BAR_WORDS;
    XcdBarrier bar; bar.bar = barw; bar.x = 0; bar.st = nullptr;
    if (hi - lo > 1) bar = xcd_barrier_post(barw, (volatile LAS unsigned*)(L + MISC_OFF) + 8);
#define IN(k) (lo <= (k) && (k) < hi)
#define TAIL_CONVERT(nwg_, ll, i0, i1) do { const int ext_ = (nwg_) % G, nt_ = ext_ ? G - ext_ : G, me_ = ext_ ? bx - ext_ : bx; \
        if (me_ >= 0) { int lane_ = lane; asm volatile("" : "+v"(lane_)); LAS float* scr_ = (LAS float*)(L + wave * TR_SCR_BYTES); \
            for (int it_ = (i0) + me_ * NWAVES + wave; it_ < (i1); it_ += nt_ * NWAVES) convert_item(args.in, ws, scr_, (ll), it_, lane_); } } while (0)
#define REPS(p) (1 + ((MK_REPEAT_MASK >> (p)) & 1))
#define SEAM(k) do { if (IN(k) && IN((k) + 1)) xcd_barrier(bar); } while (0)
#define WSP size_t wso_ = 0; asm volatile("" : "+s"(wso_)); unsigned char* ws = ws0 + wso_
#define BUFS bf16_t* XN = (bf16_t*)(ws + WS_XN); float* X = (float*)(ws + WS_X); bf16_t *Qb = (bf16_t*)(ws + WS_Q), *Kb = (bf16_t*)(ws + WS_K), *KT = (bf16_t*)(ws + WS_KT), *VT = (bf16_t*)(ws + WS_VT), *GR = (bf16_t*)(ws + WS_GR), *Ub = (bf16_t*)(ws + WS_U), \
           *Gb = (bf16_t*)(ws + WS_G), *ST = (bf16_t*)(ws + WS_ST), *PO = (bf16_t*)(ws + WS_PO), *YP = (bf16_t*)(ws + WS_YP), *YR = (bf16_t*)(ws + WS_YR), *MG = (bf16_t*)(ws + WS_MG), *Hb = (bf16_t*)(ws + WS_H); bf16_t* T1 = (bf16_t*)(ws + WS_T1); \
           (void)XN; (void)X; (void)Qb; (void)Kb; (void)KT; (void)VT; (void)GR; (void)Ub; (void)Gb; (void)ST; (void)PO; (void)YP; (void)YR; (void)MG; (void)Hb; (void)T1
    if (IN(0)) for (int rep = 0; rep < REPS(9); ++rep) { if (rep) xcd_barrier(bar);
        WSP; BUFS;
        int lane_ = lane; asm volatile("" : "+v"(lane_)); const int lane = lane_;
        LAS float* scr = (LAS float*)(L + wave * TR_SCR_BYTES);
#if MK_CONVERT_UPFRONT
        for (int it = gw; it < DEPTH * I_PER; it += NGW) convert_item(args.in, ws, scr, it / I_PER, it % I_PER, lane);
#else
        for (int it = gw; it < I_SETA; it += NGW) convert_item(args.in, ws, scr, 0, it, lane);
#endif
        for (int idx = gw * 64 + lane; idx < M * 64; idx += NGW * 64) trig_item((const int*)args.in[1], (float*)(ws + WS_TRIG), idx);
        for (int m = gw; m < M; m += NGW) rmsnorm_row(args.in[0] + (size_t)m * D, args.in[2], XN + (size_t)m * D, nullptr, lane);
    }
    SEAM(0);
    for (int l = 0; l < DEPTH; ++l) {
        const int pb = 1 + l * NPH_L;
        if (hi <= pb || lo >= pb + NPH_L) continue;
        if (IN(pb)) for (int rep = 0; rep < REPS(0); ++rep) { if (rep) xcd_barrier(bar);
            WSP; BUFS; unsigned char* wl = ws + WS_W + (size_t)l * W_STRIDE; (void)wl;
            pg8::Gemm g{XN, (const bf16_t*)(wl + WO_IN), M, INW, D, 0}; pg8::StaticOrder S; S.init(M, INW, G, bx);
            pg8::EpiIn E{Qb, Kb, KT, VT, GR, Ub, Gb, (const float*)(ws + WS_TRIG)};
            pg8::gemm_phase<pg8::EpiIn, pg8::StaticOrder, true, true>(L, g, S, E);
#if !MK_CONVERT_UPFRONT
            if (rep == 0) TAIL_CONVERT((M / 256) * (INW / 256), l, I_SETA, I_PER);
#endif
        }
        SEAM(pb);
        if (IN(pb + 1)) for (int rep = 0; rep < REPS(1); ++rep) { if (rep) xcd_barrier(bar);
            WSP; BUFS; unsigned char* wl = ws + WS_W + (size_t)l * W_STRIDE; (void)wl;
            int lane_ = lane; asm volatile("" : "+v"(lane_)); const int lane = lane_;
            { int tid_ = tid; asm volatile("" : "+v"(tid_)); for (int u = vcu; u < NB * HEADS * 16; u += G) scan_cu(L, KT, VT, ST, u, wave, lane, tid_); }
            for (int it = gw; it < PG * (M / 16); it += NGW) { const int g = it / (M / 16), run = it % (M / 16);
                if (g == 0) pooled_item<2>(Ub, PO, 0, run, lane); else if (g == 1) pooled_item<4>(Ub, PO, 1, run, lane); else if (g == 2) pooled_item<8>(Ub, PO, 2, run, lane); else pooled_item<16>(Ub, PO, 3, run, lane); }
        }
        SEAM(pb + 1);
        if (IN(pb + 2)) for (int rep = 0; rep < REPS(2); ++rep) { if (rep) xcd_barrier(bar);
            WSP; BUFS; unsigned char* wl = ws + WS_W + (size_t)l * W_STRIDE; (void)wl;
            { int lane_ = lane, tid_ = tid; asm volatile("" : "+v"(lane_), "+v"(tid_));
              retout_cu(L, Qb, Kb, VT, ST, GR, YR, vcu, G, wave, lane_, tid_); }
            pg8::Gemm g{PO, (const bf16_t*)(wl + WO_PM), M, PW, PGD, M / 256}; pg8::StaticOrder S; S.init(M, PW, G, bx);
            pg8::EpiPlain E{YP, PW};
            pg8::gemm_phase<pg8::EpiPlain, pg8::StaticOrder, true, true>(L, g, S, E);
        }
        SEAM(pb + 2);
        if (IN(pb + 3)) for (int rep = 0; rep < REPS(3); ++rep) { if (rep) xcd_barrier(bar);
            WSP; BUFS; unsigned char* wl = ws + WS_W + (size_t)l * W_STRIDE; (void)wl;
            { pg8::Gemm g{YR, (const bf16_t*)(wl + WO_RU), M, D, VW, 0}; pg8::StaticOrder S; S.init(M, D, G, bx); pg8::EpiT1 E{Gb, T1};
              pg8::gemm_phase<pg8::EpiT1, pg8::StaticOrder, true, true>(L, g, S, E); }
            { pg8::Gemm g{YP, (const bf16_t*)(wl + WO_PU), M, D, PW, 0}; pg8::StaticOrder S; S.init(M, D, G, bx); pg8::EpiMG E{Gb, T1, MG};
              pg8::gemm_phase<pg8::EpiMG, pg8::StaticOrder, true, true>(L, g, S, E); }
        }
        SEAM(pb + 3);
        if (IN(pb + 4)) for (int rep = 0; rep < REPS(4); ++rep) { if (rep) xcd_barrier(bar);
            WSP; BUFS; unsigned char* wl = ws + WS_W + (size_t)l * W_STRIDE; (void)wl;
            pg8::Gemm g{MG, (const bf16_t*)(wl + WO_O), M, D, D, 0}; pg8::StaticOrder S; S.init(M, D, G, bx); pg8::EpiResid E{l == 0 ? args.in[0] : X, rep ? (float*)T1 : X};
            pg8::gemm_phase<pg8::EpiResid, pg8::StaticOrder, true, true>(L, g, S, E);
        }
        SEAM(pb + 4);
        if (IN(pb + 5)) for (int rep = 0; rep < REPS(5); ++rep) { if (rep) xcd_barrier(bar);
            WSP; BUFS; unsigned char* wl = ws + WS_W + (size_t)l * W_STRIDE; (void)wl; int lane_ = lane; asm volatile("" : "+v"(lane_)); const int lane = lane_; for (int m = gw; m < M; m += NGW) rmsnorm_row(X + (size_t)m * D, args.in[9] + (size_t)l * D, XN + (size_t)m * D, nullptr, lane); }
        SEAM(pb + 5);
        if (IN(pb + 6)) for (int rep = 0; rep < REPS(6); ++rep) { if (rep) xcd_barrier(bar);
            WSP; BUFS; unsigned char* wl = ws + WS_W + (size_t)l * W_STRIDE; (void)wl;
            pg8::Gemm g{XN, (const bf16_t*)(wl + WO_GU), M, GUW, D, 0}; pg8::StaticOrder S; S.init(M, GUW, G, bx); pg8::EpiGU E{Hb};
            pg8::gemm_phase<pg8::EpiGU, pg8::StaticOrder, true, true>(L, g, S, E);
#if !MK_CONVERT_UPFRONT
            if (rep == 0 && l + 1 < DEPTH) TAIL_CONVERT((M / 256) * (GUW / 256), l + 1, 0, I_SETA);
#endif
        }
        SEAM(pb + 6);
        if (IN(pb + 7)) for (int rep = 0; rep < REPS(7); ++rep) { if (rep) xcd_barrier(bar);
            WSP; BUFS; unsigned char* wl = ws + WS_W + (size_t)l * W_STRIDE; (void)wl;
            pg8::Gemm g{Hb, (const bf16_t*)(wl + WO_D), M, D, DFF, 0}; pg8::StaticOrder S; S.init(M, D, G, bx); pg8::EpiResid E{X, rep ? (float*)T1 : X};
            pg8::gemm_phase<pg8::EpiResid, pg8::StaticOrder, true, true>(L, g, S, E);
        }
        SEAM(pb + 7);
        if (IN(pb + 8)) for (int rep = 0; rep < REPS(8); ++rep) { if (rep) xcd_barrier(bar);
            WSP; BUFS; unsigned char* wl = ws + WS_W + (size_t)l * W_STRIDE; (void)wl;
            int lane_ = lane; asm volatile("" : "+v"(lane_)); const int lane = lane_;
            if (l + 1 < DEPTH) { for (int m = gw; m < M; m += NGW) rmsnorm_row(X + (size_t)m * D, args.in[2] + (size_t)(l + 1) * D, XN + (size_t)m * D, nullptr, lane); }
            else { for (int m = gw; m < M; m += NGW) rmsnorm_row(X + (size_t)m * D, args.in[12], nullptr, args.out + (size_t)m * D, lane); }
        }
        SEAM(pb + 8);
    }
#undef IN
#undef SEAM
}
#if MK_NAIVE_MASK
struct Ptrs { const float* in[13]; float* out; unsigned char* ws; };
__global__ __launch_bounds__(256) void k_prologue_naive(Ptrs P) {
    __shared__ float scr_all[4][64 * 65];
    const int lane = threadIdx.x & 63, wave = threadIdx.x >> 6, gw = blockIdx.x * 4 + wave, NGW = gridDim.x * 4;
    LAS float* scr = (LAS float*)&scr_all[wave][0];
    for (int it = gw; it < DEPTH * I_PER; it += NGW) convert_item(P.in, P.ws, scr, it / I_PER, it % I_PER, lane);
    for (int idx = gw * 64 + lane; idx < M * 64; idx += NGW * 64) trig_item((const int*)P.in[1], (float*)(P.ws + WS_TRIG), idx);
}
__global__ __launch_bounds__(256) void k_rmsnorm(const float* x, const float* g, bf16_t* xn, float* fout) {
    const int lane = threadIdx.x & 63, gw = blockIdx.x * 4 + (threadIdx.x >> 6), NGW = gridDim.x * 4;
    for (int m = gw; m < M; m += NGW) rmsnorm_row(x + (size_t)m * D, g, xn ? xn + (size_t)m * D : nullptr, fout ? fout + (size_t)m * D : nullptr, lane);
}
__global__ __launch_bounds__(256) void k_gemm_naive(const bf16_t* A, int lda, const bf16_t* Bt, int ldb, float* C, int ldc, int K) {
    const int wave = threadIdx.x >> 6, lane = threadIdx.x & 63, fr = lane & 15, fq = lane >> 4;
    const int row0 = blockIdx.y * 128 + (wave >> 1) * 64, col0 = blockIdx.x * 128 + (wave & 1) * 64;
    f32x4 acc[4][4];
#pragma unroll
    for (int i = 0; i < 4; ++i)
#pragma unroll
        for (int j = 0; j < 4; ++j) acc[i][j] = (f32x4){0.f, 0.f, 0.f, 0.f};
    for (int k0 = 0; k0 < K; k0 += 32) {
        bf16x8 a[4], b[4];
#pragma unroll
        for (int i = 0; i < 4; ++i) a[i] = *(const bf16x8*)(A + (size_t)(row0 + 16 * i + fr) * lda + k0 + 8 * fq);
#pragma unroll
        for (int j = 0; j < 4; ++j) b[j] = *(const bf16x8*)(Bt + (size_t)(col0 + 16 * j + fr) * ldb + k0 + 8 * fq);
#pragma unroll
        for (int i = 0; i < 4; ++i)
#pragma unroll
            for (int j = 0; j < 4; ++j) acc[i][j] = __builtin_amdgcn_mfma_f32_16x16x32_bf16(a[i], b[j], acc[i][j], 0, 0, 0);
    }
#pragma unroll
    for (int i = 0; i < 4; ++i)
#pragma unroll
        for (int j = 0; j < 4; ++j)
#pragma unroll
            for (int r = 0; r < 4; ++r) C[(size_t)(row0 + 16 * i + 4 * fq + r) * ldc + col0 + 16 * j + fr] = acc[i][j][r];
}
__global__ void k_post_in(Ptrs P) {
    const size_t idx = (size_t)blockIdx.x * blockDim.x + threadIdx.x; if (idx >= (size_t)M * INW) return;
    const int r = (int)(idx / INW), n = (int)(idx % INW), b = r / SEQ, s = r % SEQ;
    const float* proj = (const float*)(P.ws + WS_TMP) + (size_t)r * INW;
    unsigned char* ws = P.ws;
    if (n < 2 * QKW) {
        const int sec = n / QKW, w = n % QKW, tile = w / 256, p = (w % 256) / 128, hl = (w % 128) / 64, i = w % 64; if (p) return;
        const int head = 2 * tile + hl; const float x1 = proj[n], x2 = proj[n + 128];
        const float* T = (const float*)(ws + WS_TRIG) + ((size_t)r * 64 + i) * 2; const float c = T[0], sn = T[1];
        float o1 = x1 * c - x2 * sn, o2 = x2 * c + x1 * sn;
        if (sec == 0) { o1 *= Q_SCALE; o2 *= Q_SCALE; bf16_t* Q = (bf16_t*)(ws + WS_Q) + (size_t)r * QKW + head * DK; Q[i] = f2bf(o1); Q[64 + i] = f2bf(o2); }
        else { bf16_t* Kb = (bf16_t*)(ws + WS_K) + (size_t)r * QKW + head * DK; Kb[i] = f2bf(o1); Kb[64 + i] = f2bf(o2);
               bf16_t* KT = (bf16_t*)(ws + WS_KT) + ((size_t)(b * HEADS + head) * DK) * SEQ + s; KT[(size_t)i * SEQ] = f2bf(o1); KT[(size_t)(64 + i) * SEQ] = f2bf(o2); }
    } else if (n < 2 * QKW + VW) { const int vc = n - 2 * QKW, head = vc / DV, dv = vc % DV;
        ((bf16_t*)(ws + WS_VT))[((size_t)(b * HEADS + head) * DV + dv) * SEQ + s] = f2bf(proj[n]);
    } else if (n < 2 * QKW + 2 * VW) { ((bf16_t*)(ws + WS_GR))[(size_t)r * VW + (n - 2 * QKW - VW)] = f2bf(silu_f(proj[n]));
    } else if (n < 2 * QKW + 2 * VW + PW) { ((bf16_t*)(ws + WS_U))[(size_t)r * PW + (n - 2 * QKW - 2 * VW)] = f2bf(proj[n]);
    } else { ((bf16_t*)(ws + WS_G))[(size_t)r * 2 * D + (n - 2 * QKW - 2 * VW - PW)] = f2bf(sigmoid_f(proj[n])); }
}
__global__ __launch_bounds__(256) void k_ret_naive(Ptrs P) {
    const int bh = blockIdx.x, b = bh >> 3, h = bh & 7, dv = threadIdx.x, lane = dv & 63, wave = dv >> 6;
    const bf16_t* Q = (const bf16_t*)(P.ws + WS_Q); const bf16_t* Kb = (const bf16_t*)(P.ws + WS_K); const bf16_t* VT = (const bf16_t*)(P.ws + WS_VT);
    const bf16_t* GR = (const bf16_t*)(P.ws + WS_GR); bf16_t* YR = (bf16_t*)(P.ws + WS_YR);
    const float gamma = 1.0f - exp2f(-5.0f - (float)h);
    float Sx[DK];
#pragma unroll
    for (int d = 0; d < DK; ++d) Sx[d] = 0.f;
    __shared__ float qs[DK], ks[DK], red[4];
    for (int s = 0; s < SEQ; ++s) {
        const size_t token = (size_t)b * SEQ + s;
        if (dv < DK) { qs[dv] = bf2f(Q[token * QKW + h * DK + dv]); ks[dv] = bf2f(Kb[token * QKW + h * DK + dv]); }
        const float v = bf2f(VT[((size_t)bh * DV + dv) * SEQ + s]);
        __syncthreads();
        float y = 0.f;
#pragma unroll
        for (int d = 0; d < DK; ++d) { Sx[d] = gamma * Sx[d] + ks[d] * v; y += qs[d] * Sx[d]; }
        const float ss = wave_sum(y * y);
        if (lane == 0) red[wave] = ss;
        __syncthreads();
        const float tot = (red[0] + red[1]) + (red[2] + red[3]);
        const float yn = y * rsqrtf(tot * (1.0f / DV) + NORM_EPS);
        YR[token * VW + h * DV + dv] = f2bf(yn * bf2f(GR[token * VW + h * DV + dv]));
        __syncthreads();
    }
}
__global__ void k_pooled_naive(Ptrs P) {
    const int idx = blockIdx.x * blockDim.x + threadIdx.x; if (idx >= M * PW) return;
    const int r = idx / PW, col = idx % PW, g = col / PGD, c = col % PGD, w = 2 << g, tb = r % SEQ;
    const bf16_t* U = (const bf16_t*)(P.ws + WS_U);
    const int cnt = (tb + 1 < w) ? tb + 1 : w; float sum = 0.f;
    for (int j = 0; j < cnt; ++j) sum += bf2f(U[(size_t)(r - j) * PW + col]);
    ((bf16_t*)(P.ws + WS_PO))[((size_t)g * M + r) * PGD + c] = f2bf(sum / (float)cnt - bf2f(U[(size_t)r * PW + col]));
}
__global__ void k_f32_to_bf16(const float* in, bf16_t* out, size_t n) { const size_t i = (size_t)blockIdx.x * blockDim.x + threadIdx.x; if (i < n) out[i] = f2bf(in[i]); }
__global__ void k_merge(Ptrs P) {
    const size_t i = (size_t)blockIdx.x * blockDim.x + threadIdx.x; if (i >= (size_t)M * D) return;
    const size_t r = i / D, c = i % D; const float* tmp = (const float*)(P.ws + WS_TMP); const bf16_t* G = (const bf16_t*)(P.ws + WS_G);
    ((bf16_t*)(P.ws + WS_MG))[i] = f2bf(bf2f(G[r * 2 * D + c]) * tmp[i] + bf2f(G[r * 2 * D + D + c]) * tmp[(size_t)M * D + i]);
}
__global__ void k_resid(const float* base, const float* add, float* out, size_t n) { const size_t i = (size_t)blockIdx.x * blockDim.x + threadIdx.x; if (i < n) out[i] = base[i] + add[i]; }
__global__ void k_swiglu(Ptrs P) {
    const size_t i = (size_t)blockIdx.x * blockDim.x + threadIdx.x; if (i >= (size_t)M * DFF) return;
    const size_t r = i / DFF; const int j = (int)(i % DFF), tile = j / 128, jj = j % 128; const float* t = (const float*)(P.ws + WS_TMP) + r * GUW + tile * 256;
    ((bf16_t*)(P.ws + WS_H))[i] = f2bf(silu_f(t[jj]) * t[128 + jj]);
}
static void gemm_naive(hipStream_t st, const bf16_t* A, int lda, const bf16_t* Bt, int ldb, float* C, int ldc, int Mr, int N, int K) {
    hipLaunchKernelGGL(k_gemm_naive, dim3(N / 128, Mr / 128), dim3(256), 0, st, A, lda, Bt, ldb, C, ldc, K);
}
static void naive_stage(hipStream_t stream, const Ptrs& P, int l, int p) {
    unsigned char* ws = P.ws; unsigned char* wl = ws + WS_W + (size_t)l * W_STRIDE;
    float* X = (float*)(ws + WS_X); bf16_t* XN = (bf16_t*)(ws + WS_XN); float* TMP = (float*)(ws + WS_TMP);
    const float* xin = l == 0 ? P.in[0] : X;
    switch (p) {
    case 0: gemm_naive(stream, XN, D, (const bf16_t*)(wl + WO_IN), D, TMP, INW, M, INW, D);
            hipLaunchKernelGGL(k_post_in, dim3((unsigned)(((size_t)M * INW + 255) / 256)), dim3(256), 0, stream, P); break;
    case 1: hipLaunchKernelGGL(k_pooled_naive, dim3(M * PW / 256), dim3(256), 0, stream, P); break;
    case 2: hipLaunchKernelGGL(k_ret_naive, dim3(NB * HEADS), dim3(256), 0, stream, P);
            for (int g = 0; g < PG; ++g) gemm_naive(stream, (const bf16_t*)(ws + WS_PO) + (size_t)g * M * PGD, PGD, (const bf16_t*)(wl + WO_PM) + (size_t)g * PGD * PGD, PGD, TMP + g * PGD, PW, M, PGD, PGD);
            hipLaunchKernelGGL(k_f32_to_bf16, dim3(M * PW / 256), dim3(256), 0, stream, (const float*)TMP, (bf16_t*)(ws + WS_YP), (size_t)M * PW); break;
    case 3: gemm_naive(stream, (const bf16_t*)(ws + WS_YR), VW, (const bf16_t*)(wl + WO_RU), VW, TMP, D, M, D, VW);
            gemm_naive(stream, (const bf16_t*)(ws + WS_YP), PW, (const bf16_t*)(wl + WO_PU), PW, TMP + (size_t)M * D, D, M, D, PW);
            hipLaunchKernelGGL(k_merge, dim3(M * D / 256), dim3(256), 0, stream, P); break;
    case 4: gemm_naive(stream, (const bf16_t*)(ws + WS_MG), D, (const bf16_t*)(wl + WO_O), D, TMP, D, M, D, D);
            hipLaunchKernelGGL(k_resid, dim3(M * D / 256), dim3(256), 0, stream, xin, (const float*)TMP, X, (size_t)M * D); break;
    case 5: hipLaunchKernelGGL(k_rmsnorm, dim3(1024), dim3(256), 0, stream, (const float*)X, P.in[9] + (size_t)l * D, XN, (float*)nullptr); break;
    case 6: gemm_naive(stream, XN, D, (const bf16_t*)(wl + WO_GU), D, TMP, GUW, M, GUW, D);
            hipLaunchKernelGGL(k_swiglu, dim3((unsigned)(((size_t)M * DFF + 255) / 256)), dim3(256), 0, stream, P); break;
    case 7: gemm_naive(stream, (const bf16_t*)(ws + WS_H), DFF, (const bf16_t*)(wl + WO_D), DFF, TMP, D, M, D, DFF);
            hipLaunchKernelGGL(k_resid, dim3(M * D / 256), dim3(256), 0, stream, (const float*)X, (const float*)TMP, X, (size_t)M * D); break;
    default: if (l + 1 < DEPTH) hipLaunchKernelGGL(k_rmsnorm, dim3(1024), dim3(256), 0, stream, (const float*)X, P.in[2] + (size_t)(l + 1) * D, XN, (float*)nullptr);
             else hipLaunchKernelGGL(k_rmsnorm, dim3(1024), dim3(256), 0, stream, (const float*)X, P.in[12], (bf16_t*)nullptr, P.out); break;
    }
}
#endif
static void launch_fwd(hipStream_t stream, int grid, Args a, int lo, int hi, int li) {
    a.ph_lo = lo; a.ph_hi = hi; a.li = li; a.pad = 0;
    hipLaunchKernelGGL(fwd, dim3(grid), dim3(NWAVES * 64), LDS_BYTES, stream, a);
    const hipError_t le = hipPeekAtLastError();
    if (le != hipSuccess) fprintf(stderr, "kernel_launch: launch of phases [%d,%d) failed: %s (grid %d x %d threads, %d B LDS)\n", lo, hi, hipGetErrorName(le), grid, NWAVES * 64, LDS_BYTES);
}
extern "C" void kernel_launch(void* const* d_in, const int* in_sizes, int n_in, void* d_out, int out_size, void* d_ws, size_t ws_size, hipStream_t stream) {
    static int grid = 0;
    if (grid == 0) {
        const size_t need = MK_NAIVE_MASK ? WS_TMP + 352 * MiB : WS_BEND;
        if (n_in != 13 || in_sizes[0] != M * D || out_size != M * D || ws_size < need) { fprintf(stderr, "kernel_launch: built for 13 inputs, x/out of %d floats and >= %zu bytes of workspace; got n_in %d, ws %zu; nothing launched\n", M * D, need, n_in, ws_size); grid = -1; return; }
        int dev = 0, cus = 0, per_cu = 0;
        if (hipGetDevice(&dev) != hipSuccess || hipDeviceGetAttribute(&cus, hipDeviceAttributeMultiprocessorCount, dev) != hipSuccess) { fprintf(stderr, "kernel_launch: device query failed\n"); grid = -1; return; }
        if (hipFuncSetAttribute((const void*)fwd, hipFuncAttributeMaxDynamicSharedMemorySize, LDS_BYTES) != hipSuccess) { fprintf(stderr, "kernel_launch: hipFuncSetAttribute failed\n"); grid = -1; return; }
        if (hipOccupancyMaxActiveBlocksPerMultiprocessor(&per_cu, (const void*)fwd, NWAVES * 64, LDS_BYTES) != hipSuccess || per_cu < 1) { fprintf(stderr, "kernel_launch: occupancy query says %d workgroups per CU; nothing launched\n", per_cu); grid = -1; (void)hipGetLastError(); return; }
        grid = cus;
    }
    if (grid < 0) return;
    if (hipMemsetAsync((char*)d_ws + WS_CTL, 0, CTL_ZERO_BYTES, stream) != hipSuccess) { fprintf(stderr, "kernel_launch: memset failed\n"); return; }
    Args a{};
    for (int i = 0; i < 13; ++i) a.in[i] = (const float*)d_in[i];
    a.out = (float*)d_out; a.ws = (unsigned char*)d_ws;
#if MK_LAUNCHES == 1
    launch_fwd(stream, grid, a, 0, NPHASES, 0);
#else
#if MK_NAIVE_MASK
    Ptrs P{}; for (int i = 0; i < 13; ++i) P.in[i] = a.in[i]; P.out = a.out; P.ws = a.ws;
#endif
    int li = 0;
#if MK_NAIVE_MASK & 512
    hipLaunchKernelGGL(k_prologue_naive, dim3(2048), dim3(256), 0, stream, P);
    hipLaunchKernelGGL(k_rmsnorm, dim3(1024), dim3(256), 0, stream, P.in[0], P.in[2], (bf16_t*)(P.ws + WS_XN), (float*)nullptr);
#else
    launch_fwd(stream, grid, a, 0, 1, li++);
#endif
    for (int l = 0; l < DEPTH; ++l)
        for (int p = 0; p < NPH_L; ++p) {
#if MK_NAIVE_MASK
            if ((MK_NAIVE_MASK >> p) & 1) { naive_stage(stream, P, l, p); continue; }
#endif
            launch_fwd(stream, grid, a, 1 + l * NPH_L + p, 2 + l * NPH_L + p, li++);
        }
#endif
}
```

```cpp
#define MK_LAUNCHES 1
#define MK_REPEAT_MASK 0
#define MK_CONVERT_UPFRONT 0
#define MK_NAIVE_MASK 0
#include <hip/hip_runtime.h>
#include <stdint.h>
#include <stdio.h>

#define LAS __attribute__((address_space(3)))
typedef unsigned short bf16_t;
typedef short bf16x8 __attribute__((ext_vector_type(8)));
typedef float f32x4 __attribute__((ext_vector_type(4)));
typedef unsigned u32x4 __attribute__((ext_vector_type(4)));
typedef unsigned u32x2 __attribute__((ext_vector_type(2)));

constexpr int D = 2048, NB = 2, SEQ = 4096, M = NB * SEQ, DEPTH = 4;
constexpr int HEADS = 8, DK = 128, DV = 256, QKW = 1024, VW = 2048, CHUNK = 128, NCH = SEQ / CHUNK;
constexpr int PW = 1024, PG = 4, PGD = 256;
constexpr int INW = 11264, DFF = 5632, GUW = 2 * DFF;
constexpr float NORM_EPS = 1e-6f;
constexpr float Q_SCALE = 0.08838834764831845f;

constexpr size_t MiB = 1u << 20;
constexpr size_t WS_CTL = 0, CTL_ZERO_BYTES = 1 * MiB;
constexpr size_t WS_TRIG = 1 * MiB;
constexpr size_t WS_W = 8 * MiB, W_STRIDE = 131 * MiB;
constexpr size_t WO_IN = 0, WO_GU = 44 * MiB, WO_D = 88 * MiB, WO_RU = 110 * MiB, WO_PU = 118 * MiB, WO_O = 122 * MiB, WO_PM = 130 * MiB;
constexpr size_t WS_X = 532 * MiB;
constexpr size_t WS_XN = 596 * MiB;
constexpr size_t WS_B = 628 * MiB;
constexpr size_t WS_Q = WS_B, WS_K = WS_Q + 16 * MiB, WS_KT = WS_K + 16 * MiB, WS_VT = WS_KT + 16 * MiB, WS_GR = WS_VT + 32 * MiB, WS_U = WS_GR + 32 * MiB,
                 WS_G = WS_U + 16 * MiB, WS_ST = WS_G + 64 * MiB, WS_PO = WS_ST + 32 * MiB, WS_YP = WS_PO + 16 * MiB, WS_YR = WS_YP + 16 * MiB,
                 WS_T1 = WS_YR + 32 * MiB, WS_MG = WS_T1 + 64 * MiB, WS_BEND = WS_MG + 32 * MiB;
constexpr size_t WS_H = WS_B;
constexpr size_t WS_TMP = WS_BEND;
static_assert(WS_BEND == 1012 * MiB, "map");
constexpr int CW_BAR = 4096;

__device__ __forceinline__ float bf2f(bf16_t v) { return __uint_as_float(((unsigned)v) << 16); }
__device__ __forceinline__ bf16_t f2bf(float f) { unsigned u = __float_as_uint(f); u += 0x7fffu + ((u >> 16) & 1u); return (bf16_t)(u >> 16); }
__device__ __forceinline__ unsigned pk2(float lo, float hi) { return (unsigned)f2bf(lo) | ((unsigned)f2bf(hi) << 16); }
__device__ __forceinline__ float silu_f(float x) { return x / (1.0f + __expf(-x)); }
__device__ __forceinline__ float sigmoid_f(float x) { return 1.0f / (1.0f + __expf(-x)); }
__device__ __forceinline__ float wave_sum(float v) {
#pragma unroll
    for (int o = 1; o < 64; o <<= 1) v += __shfl_xor(v, o);
    return v;
}
__host__ __device__ __forceinline__ int map_row(int mode, int n) {
    if (mode == 1) { if (n >= 2 * QKW) return n; const int sec = n / QKW, w = n % QKW, head = w / DK, p = (w % DK) / 64, i = w % 64; return sec * QKW + (head >> 1) * 256 + 128 * p + (head & 1) * 64 + i; }
    if (mode == 2) { const int p = n / DFF, j = n % DFF; return (j / 128) * 256 + 128 * p + (j % 128); }
    return n;
}

constexpr int TR_SCR_BYTES = 64 * 65 * 4;
__device__ __forceinline__ void transpose_item(const float* W, int K, int N, bf16_t* WT, int mode, const float* nscale, LAS float* scr, int item, int lane) {
    const int kblk = K / 64, nb = item / kblk, kb = item % kblk, k0 = 64 * kb, n0 = 64 * nb;
    const float* src = W + (size_t)(k0 + (lane >> 4)) * N + n0 + 4 * (lane & 15);
    f32x4 v[16];
#pragma unroll
    for (int i = 0; i < 16; ++i) v[i] = __builtin_nontemporal_load((const f32x4*)(src + (size_t)(4 * i) * N));
    LAS float* d = scr + (lane >> 4) * 65 + 4 * (lane & 15);
#pragma unroll
    for (int i = 0; i < 16; ++i) { d[(4 * i) * 65 + 0] = v[i].x; d[(4 * i) * 65 + 1] = v[i].y; d[(4 * i) * 65 + 2] = v[i].z; d[(4 * i) * 65 + 3] = v[i].w; }
    asm volatile("s_waitcnt lgkmcnt(0)" ::: "memory");
    const int c = lane & 7, d0 = map_row(mode, n0);
#pragma unroll
    for (int j = 0; j < 8; ++j) { const int n = (lane >> 3) + 8 * j; const LAS float* s = scr + (8 * c) * 65 + n; const float sc = nscale ? nscale[n0 + n] : 1.0f;
        u32x4 o; o.x = pk2(s[0 * 65] * sc, s[1 * 65] * sc); o.y = pk2(s[2 * 65] * sc, s[3 * 65] * sc); o.z = pk2(s[4 * 65] * sc, s[5 * 65] * sc); o.w = pk2(s[6 * 65] * sc, s[7 * 65] * sc);
        *(u32x4*)(WT + (size_t)(d0 + n) * K + k0 + 8 * c) = o; }
    asm volatile("s_waitcnt lgkmcnt(0)" ::: "memory");
}
constexpr int I_IN = (D / 64) * (INW / 64), I_GU = (D / 64) * (GUW / 64), I_D = (DFF / 64) * (D / 64), I_RU = (VW / 64) * (D / 64), I_PU = (PW / 64) * (D / 64), I_O = (D / 64) * (D / 64), I_PM = PG * (PGD / 64) * (PGD / 64);
constexpr int I_SETA = I_IN + I_RU + I_PU + I_O + I_PM;
constexpr int I_PER = I_SETA + I_GU + I_D;
__device__ __forceinline__ void convert_item(const float* const* in, unsigned char* ws, LAS float* scr, int l, int r, int lane) {
    unsigned char* wl = ws + WS_W + (size_t)l * W_STRIDE;
    if (r < I_IN) { transpose_item(in[3] + (size_t)l * D * INW, D, INW, (bf16_t*)(wl + WO_IN), 1, nullptr, scr, r, lane); return; } r -= I_IN;
    if (r < I_RU) { transpose_item(in[6] + (size_t)l * VW * D, VW, D, (bf16_t*)(wl + WO_RU), 0, nullptr, scr, r, lane); return; } r -= I_RU;
    if (r < I_PU) { transpose_item(in[7] + (size_t)l * PW * D, PW, D, (bf16_t*)(wl + WO_PU), 0, nullptr, scr, r, lane); return; } r -= I_PU;
    if (r < I_O) { transpose_item(in[8] + (size_t)l * D * D, D, D, (bf16_t*)(wl + WO_O), 0, nullptr, scr, r, lane); return; } r -= I_O;
    if (r < I_PM) { const int g = r / ((PGD / 64) * (PGD / 64)), rr = r % ((PGD / 64) * (PGD / 64));
      transpose_item(in[4] + ((size_t)l * PG + g) * PGD * PGD, PGD, PGD, (bf16_t*)(wl + WO_PM) + (size_t)g * PGD * PGD, 0, in[5] + (size_t)l * PW + g * PGD, scr, rr, lane); return; } r -= I_PM;
    if (r < I_GU) { transpose_item(in[10] + (size_t)l * D * GUW, D, GUW, (bf16_t*)(wl + WO_GU), 2, nullptr, scr, r, lane); return; } r -= I_GU;
    transpose_item(in[11] + (size_t)l * DFF * D, DFF, D, (bf16_t*)(wl + WO_D), 0, nullptr, scr, r, lane);
}
__device__ __forceinline__ void trig_item(const int* positions, float* T, int idx) {
    const int token = idx >> 6, i = idx & 63;
    const int pos = positions[token];
    const float inv_freq = (float)exp2(-(double)i / 64.0 * 13.287712379549449);
    const float ang = (float)pos * inv_freq;
    const double x = (double)ang, k = rint(x * 0.63661977236758134308);
    double r = fma(-k, 1.57079632679489655800, x); r = fma(-k, 6.12323399573676603587e-17, r);
    const int q = ((int)k) & 3; const double r2 = r * r;
    const double sp = r * (1.0 + r2 * (-1.0 / 6 + r2 * (1.0 / 120 + r2 * (-1.0 / 5040 + r2 * (1.0 / 362880 + r2 * (-1.0 / 39916800 + r2 * (1.0 / 6227020800.0)))))));
    const double cp = 1.0 + r2 * (-0.5 + r2 * (1.0 / 24 + r2 * (-1.0 / 720 + r2 * (1.0 / 40320 + r2 * (-1.0 / 3628800 + r2 * (1.0 / 479001600 + r2 * (-1.0 / 87178291200.0)))))));
    double s, c;
    if (q == 0) { s = sp; c = cp; } else if (q == 1) { s = cp; c = -sp; } else if (q == 2) { s = -sp; c = -cp; } else { s = -cp; c = sp; }
    T[2 * idx] = (float)c; T[2 * idx + 1] = (float)s;
}
__device__ __forceinline__ void rmsnorm_row(const float* xrow, const float* g, bf16_t* orow, float* frow, int lane) {
    const f32x4* xr = (const f32x4*)xrow + lane; const f32x4* gr = (const f32x4*)g + lane;
    f32x4 v[8]; float s = 0.f;
#pragma unroll
    for (int j = 0; j < 8; ++j) { v[j] = xr[64 * j]; s += (v[j].x * v[j].x + v[j].y * v[j].y) + (v[j].z * v[j].z + v[j].w * v[j].w); }
    const float rstd = rsqrtf(wave_sum(s) * (1.0f / D) + NORM_EPS);
#pragma unroll
    for (int j = 0; j < 8; ++j) { const f32x4 gg = gr[64 * j]; const f32x4 o = v[j] * rstd * gg;
        if (orow) { u32x2 w; w.x = pk2(o.x, o.y); w.y = pk2(o.z, o.w); *((u32x2*)orow + lane + 64 * j) = w; }
        else *((f32x4*)frow + lane + 64 * j) = o; }
}
namespace pg8 {
#define PG8_LAS __attribute__((address_space(3)))
typedef unsigned short bf16_t;
typedef short bf16x8 __attribute__((ext_vector_type(8)));
typedef float f32x4 __attribute__((ext_vector_type(4)));
typedef unsigned u32x4 __attribute__((ext_vector_type(4)));
constexpr int BM = 256, BK = 64, HALF = 128, HTB = HALF * BK * 2  , STAGE_BYTES = 8 * HTB, NXCD = 8, WGM = 8;

__host__ __device__ __forceinline__ int lds_byte(int r, int c) { const int st = (r >> 4) * 2 + (c >> 5), rr = r & 15, cc = c & 31, ob = rr * 64 + cc * 2; return st * 1024 + (ob ^ (((ob >> 9) & 1) << 5)); }
__host__ __device__ __forceinline__ void stage_rc(int b, int& R, int& C) { const int st = b / 1024, sb = b % 1024, swz = sb ^ (((sb >> 9) & 1) << 5); R = (st >> 1) * 16 + swz / 64; C = (st & 1) * 32 + (swz % 64) / 2; }
__host__ __device__ __forceinline__ int perm32(int rho) { const int n = rho >> 4, i = rho & 15; return 8 * (i >> 2) + 4 * n + (i & 3); }

struct Unit { int pm, pn; };
struct Gemm { const bf16_t* A; const bf16_t* Bt; int M, N, K, apn; };

struct StaticOrder {
    int nM, nN, nwg, G, c;
    __host__ __device__ void init(int M, int N, int G_, int c_) { nM = M / BM; nN = N / BM; nwg = nM * nN; G = G_; c = c_; }
    __host__ __device__ bool next(int i, Unit& u) const {
        const long L = (long)i * G + c; if (L >= nwg) return false;
        int wgid = (int)L; { const int q = nwg / NXCD, r = nwg % NXCD, xcd = wgid % NXCD, off = wgid / NXCD; wgid = (xcd < r ? xcd * (q + 1) : r * (q + 1) + (xcd - r) * q) + off; }
        const int nig = WGM * nN, gid = wgid / nig, fm = gid * WGM, gsz = (nM - fm) < WGM ? (nM - fm) : WGM;
        u.pm = fm + ((wgid % nig) % gsz); u.pn = (wgid % nig) / gsz; return true;
    }
    __device__ __forceinline__ void a_ready(const Unit&) const {}
    __device__ __forceinline__ void done(const Unit&) const {}
};
typedef float f32x2c __attribute__((ext_vector_type(2))); typedef __bf16 bf16x2c __attribute__((ext_vector_type(2)));
__device__ __forceinline__ unsigned cvt_pk_bf16(float lo, float hi) { const f32x2c v = {lo, hi}; return __builtin_bit_cast(unsigned, __builtin_convertvector(v, bf16x2c)); }
typedef unsigned u32x2 __attribute__((ext_vector_type(2)));
__device__ __forceinline__ float silu_e(float x) { return x * __builtin_amdgcn_rcpf(1.0f + __expf(-x)); }
__device__ __forceinline__ float sigm_e(float x) { return __builtin_amdgcn_rcpf(1.0f + __expf(-x)); }
__device__ __forceinline__ u32x4 pack8(const f32x4 v0, const f32x4 v1) { u32x4 w; w.x = cvt_pk_bf16(v0[0], v0[1]); w.y = cvt_pk_bf16(v0[2], v0[3]); w.z = cvt_pk_bf16(v1[0], v1[1]); w.w = cvt_pk_bf16(v1[2], v1[3]); return w; }
__device__ __forceinline__ float bflo(unsigned w) { return __uint_as_float(w << 16); }
__device__ __forceinline__ float bfhi(unsigned w) { return __uint_as_float(w & 0xffff0000u); }

struct EpiIn {
    static constexpr bool PERM = true, AFTER_DRAIN = false;
    bf16_t *Q, *Kb, *KT, *VT, *GR, *U, *G; const float* TRIG;
    template <int SEC> __device__ __forceinline__ void rot(bf16_t* O, const f32x4 (&acc)[2][2][4][2], int t, int rbase, int wc, int fq) const {
        const int head = 2 * t + (wc >> 1), i0 = 32 * (wc & 1) + 8 * fq;
        const float sc = SEC == 0 ? Q_SCALE : 1.0f;
#pragma unroll
        for (int ai = 0; ai < 2; ++ai)
#pragma unroll
            for (int m = 0; m < 4; ++m) {
                const int r = rbase + ai * HALF + m * 16;
                const f32x4* T = (const f32x4*)(TRIG + ((size_t)r * 64 + i0) * 2);
                const f32x4 t0 = T[0], t1 = T[1], t2 = T[2], t3 = T[3];
                const f32x4 xa = acc[ai][0][m][0], xb = acc[ai][0][m][1], ya = acc[ai][1][m][0], yb = acc[ai][1][m][1];
                f32x4 pa, pb, qa, qb;
                pa[0] = (xa[0] * t0[0] - ya[0] * t0[1]) * sc; qa[0] = (ya[0] * t0[0] + xa[0] * t0[1]) * sc;
                pa[1] = (xa[1] * t0[2] - ya[1] * t0[3]) * sc; qa[1] = (ya[1] * t0[2] + xa[1] * t0[3]) * sc;
                pa[2] = (xa[2] * t1[0] - ya[2] * t1[1]) * sc; qa[2] = (ya[2] * t1[0] + xa[2] * t1[1]) * sc;
                pa[3] = (xa[3] * t1[2] - ya[3] * t1[3]) * sc; qa[3] = (ya[3] * t1[2] + xa[3] * t1[3]) * sc;
                pb[0] = (xb[0] * t2[0] - yb[0] * t2[1]) * sc; qb[0] = (yb[0] * t2[0] + xb[0] * t2[1]) * sc;
                pb[1] = (xb[1] * t2[2] - yb[1] * t2[3]) * sc; qb[1] = (yb[1] * t2[2] + xb[1] * t2[3]) * sc;
                pb[2] = (xb[2] * t3[0] - yb[2] * t3[1]) * sc; qb[2] = (yb[2] * t3[0] + xb[2] * t3[1]) * sc;
                pb[3] = (xb[3] * t3[2] - yb[3] * t3[3]) * sc; qb[3] = (yb[3] * t3[2] + xb[3] * t3[3]) * sc;
                const u32x4 w1 = pack8(pa, pb), w2 = pack8(qa, qb);
                bf16_t* rowp = O + (size_t)r * QKW + head * DK + i0;
                *(u32x4*)rowp = w1; *(u32x4*)(rowp + 64) = w2;
                if (SEC == 1) {
                    bf16_t* kt = KT + ((size_t)((r >> 12) * HEADS + head) * DK + i0) * SEQ + (r & (SEQ - 1));
                    kt[(size_t)0 * SEQ] = (bf16_t)(w1.x & 0xffffu); kt[(size_t)1 * SEQ] = (bf16_t)(w1.x >> 16); kt[(size_t)2 * SEQ] = (bf16_t)(w1.y & 0xffffu); kt[(size_t)3 * SEQ] = (bf16_t)(w1.y >> 16);
                    kt[(size_t)4 * SEQ] = (bf16_t)(w1.z & 0xffffu); kt[(size_t)5 * SEQ] = (bf16_t)(w1.z >> 16); kt[(size_t)6 * SEQ] = (bf16_t)(w1.w & 0xffffu); kt[(size_t)7 * SEQ] = (bf16_t)(w1.w >> 16);
                    kt[(size_t)64 * SEQ] = (bf16_t)(w2.x & 0xffffu); kt[(size_t)65 * SEQ] = (bf16_t)(w2.x >> 16); kt[(size_t)66 * SEQ] = (bf16_t)(w2.y & 0xffffu); kt[(size_t)67 * SEQ] = (bf16_t)(w2.y >> 16);
                    kt[(size_t)68 * SEQ] = (bf16_t)(w2.z & 0xffffu); kt[(size_t)69 * SEQ] = (bf16_t)(w2.z >> 16); kt[(size_t)70 * SEQ] = (bf16_t)(w2.w & 0xffffu); kt[(size_t)71 * SEQ] = (bf16_t)(w2.w >> 16);
                }
                asm volatile("" ::: "memory");
            }
    }
    template <int ACT> __device__ __forceinline__ void rows(bf16_t* O, int ldc, int colt, const f32x4 (&acc)[2][2][4][2], int rbase, int cl) const {
#pragma unroll
        for (int ai = 0; ai < 2; ++ai)
#pragma unroll
            for (int m = 0; m < 4; ++m) { bf16_t* rowp = O + (size_t)(rbase + ai * HALF + m * 16) * ldc + colt + cl;
#pragma unroll
                for (int bj = 0; bj < 2; ++bj) { f32x4 v0 = acc[ai][bj][m][0], v1 = acc[ai][bj][m][1];
                    if (ACT == 1) {
#pragma unroll
                        for (int e = 0; e < 4; ++e) { v0[e] = silu_e(v0[e]); v1[e] = silu_e(v1[e]); } }
                    if (ACT == 2) {
#pragma unroll
                        for (int e = 0; e < 4; ++e) { v0[e] = sigm_e(v0[e]); v1[e] = sigm_e(v1[e]); } }
                    *(u32x4*)(rowp + bj * HALF) = pack8(v0, v1); } }
    }
    __device__ __forceinline__ void operator()(const f32x4 (&acc)[2][2][4][2], const Unit& u, int wr, int wc, int fr_, int fq_) const {
        int fr = fr_, fq = fq_; asm volatile("" : "+v"(fr), "+v"(fq));
        const int pn = u.pn, rbase = u.pm * BM + wr * 64 + fr, cl = wc * 32 + 8 * fq;
        if (pn < 4) rot<0>(Q, acc, pn, rbase, wc, fq);
        else if (pn < 8) rot<1>(Kb, acc, pn - 4, rbase, wc, fq);
        else if (pn < 16) {
            const int head = pn - 8;
#pragma unroll
            for (int ai = 0; ai < 2; ++ai)
#pragma unroll
                for (int m = 0; m < 4; ++m) {
                    const int r = rbase + ai * HALF + m * 16;
                    bf16_t* vt = VT + ((size_t)((r >> 12) * HEADS + head) * DV + cl) * SEQ + (r & (SEQ - 1));
#pragma unroll
                    for (int bj = 0; bj < 2; ++bj)
#pragma unroll
                        for (int n = 0; n < 2; ++n) { const f32x4 v = acc[ai][bj][m][n]; const unsigned p0 = cvt_pk_bf16(v[0], v[1]), p1 = cvt_pk_bf16(v[2], v[3]);
                            bf16_t* q = vt + (size_t)(bj * HALF + 4 * n) * SEQ;
                            q[0] = (bf16_t)(p0 & 0xffffu); q[(size_t)SEQ] = (bf16_t)(p0 >> 16); q[(size_t)2 * SEQ] = (bf16_t)(p1 & 0xffffu); q[(size_t)3 * SEQ] = (bf16_t)(p1 >> 16); }
                }
        }
        else if (pn < 24) rows<1>(GR, VW, (pn - 16) * BM, acc, rbase, cl);
        else if (pn < 28) rows<0>(U, PW, (pn - 24) * BM, acc, rbase, cl);
        else rows<2>(G, 2 * D, (pn - 28) * BM, acc, rbase, cl);
    }
};
struct EpiGU {
    static constexpr bool PERM = true, AFTER_DRAIN = false;
    bf16_t* H;
    __device__ __forceinline__ void operator()(const f32x4 (&acc)[2][2][4][2], const Unit& u, int wr, int wc, int fr_, int fq_) const {
        int fr = fr_, fq = fq_; asm volatile("" : "+v"(fr), "+v"(fq));
        const int rbase = u.pm * BM + wr * 64 + fr, col = u.pn * HALF + wc * 32 + 8 * fq;
#pragma unroll
        for (int ai = 0; ai < 2; ++ai)
#pragma unroll
            for (int m = 0; m < 4; ++m) { f32x4 v0 = acc[ai][0][m][0], v1 = acc[ai][0][m][1]; const f32x4 u0 = acc[ai][1][m][0], u1 = acc[ai][1][m][1];
#pragma unroll
                for (int e = 0; e < 4; ++e) { v0[e] = silu_e(v0[e]) * u0[e]; v1[e] = silu_e(v1[e]) * u1[e]; }
                *(u32x4*)(H + (size_t)(rbase + ai * HALF + m * 16) * DFF + col) = pack8(v0, v1); }
    }
};
struct EpiResid {
    static constexpr bool PERM = false, AFTER_DRAIN = false;
    const float* base; float* out;
    __device__ __forceinline__ void operator()(const f32x4 (&acc)[2][2][4][2], const Unit& u, int wr, int wc, int fr_, int fq_) const {
        int fr = fr_, fq = fq_; asm volatile("" : "+v"(fr), "+v"(fq));
        const int row0 = u.pm * BM + wr * 64 + fr, col0 = u.pn * BM + wc * 32 + 4 * fq;
#pragma unroll
        for (int ai = 0; ai < 2; ++ai)
#pragma unroll
            for (int m = 0; m < 4; ++m) { const size_t off = (size_t)(row0 + ai * HALF + m * 16) * D + col0;
#pragma unroll
                for (int bj = 0; bj < 2; ++bj)
#pragma unroll
                    for (int n = 0; n < 2; ++n) { const f32x4 b = *(const f32x4*)(base + off + bj * HALF + n * 16); *(f32x4*)(out + off + bj * HALF + n * 16) = b + acc[ai][bj][m][n]; } }
    }
};
struct EpiT1 {
    static constexpr bool PERM = true, AFTER_DRAIN = false;
    const bf16_t* G; bf16_t* T1;
    __device__ __forceinline__ void operator()(const f32x4 (&acc)[2][2][4][2], const Unit& u, int wr, int wc, int fr_, int fq_) const {
        int fr = fr_, fq = fq_; asm volatile("" : "+v"(fr), "+v"(fq));
        const int rbase = u.pm * BM + wr * 64 + fr, col = u.pn * BM + wc * 32 + 8 * fq;
#pragma unroll
        for (int ai = 0; ai < 2; ++ai)
#pragma unroll
            for (int m = 0; m < 4; ++m) { const int r = rbase + ai * HALF + m * 16;
#pragma unroll
                for (int bj = 0; bj < 2; ++bj) { const u32x4 g = *(const u32x4*)(G + (size_t)r * (2 * D) + col + bj * HALF);
                    const f32x4 g0 = {bflo(g.x), bfhi(g.x), bflo(g.y), bfhi(g.y)}, g1 = {bflo(g.z), bfhi(g.z), bflo(g.w), bfhi(g.w)};
                    *(u32x4*)(T1 + (size_t)r * D + col + bj * HALF) = pack8(g0 * acc[ai][bj][m][0], g1 * acc[ai][bj][m][1]); } }
    }
};
struct EpiMG {
    static constexpr bool PERM = true, AFTER_DRAIN = false;
    const bf16_t* G; const bf16_t* T1; bf16_t* MG;
    __device__ __forceinline__ void operator()(const f32x4 (&acc)[2][2][4][2], const Unit& u, int wr, int wc, int fr_, int fq_) const {
        int fr = fr_, fq = fq_; asm volatile("" : "+v"(fr), "+v"(fq));
        const int rbase = u.pm * BM + wr * 64 + fr, col = u.pn * BM + wc * 32 + 8 * fq;
#pragma unroll
        for (int ai = 0; ai < 2; ++ai)
#pragma unroll
            for (int m = 0; m < 4; ++m) { const int r = rbase + ai * HALF + m * 16;
#pragma unroll
                for (int bj = 0; bj < 2; ++bj) { const u32x4 g = *(const u32x4*)(G + (size_t)r * (2 * D) + D + col + bj * HALF), t = *(const u32x4*)(T1 + (size_t)r * D + col + bj * HALF);
                    const f32x4 g0 = {bflo(g.x), bfhi(g.x), bflo(g.y), bfhi(g.y)}, g1 = {bflo(g.z), bfhi(g.z), bflo(g.w), bfhi(g.w)};
                    const f32x4 t0 = {bflo(t.x), bfhi(t.x), bflo(t.y), bfhi(t.y)}, t1 = {bflo(t.z), bfhi(t.z), bflo(t.w), bfhi(t.w)};
                    *(u32x4*)(MG + (size_t)r * D + col + bj * HALF) = pack8(t0 + g0 * acc[ai][bj][m][0], t1 + g1 * acc[ai][bj][m][1]); } }
    }
};
struct EpiPlain {
    static constexpr bool PERM = true, AFTER_DRAIN = false;
    bf16_t* O; int ldc;
    __device__ __forceinline__ void operator()(const f32x4 (&acc)[2][2][4][2], const Unit& u, int wr, int wc, int fr_, int fq_) const {
        int fr = fr_, fq = fq_; asm volatile("" : "+v"(fr), "+v"(fq));
        const int rbase = u.pm * BM + wr * 64 + fr, col = u.pn * BM + wc * 32 + 8 * fq;
#pragma unroll
        for (int ai = 0; ai < 2; ++ai)
#pragma unroll
            for (int m = 0; m < 4; ++m)
#pragma unroll
                for (int bj = 0; bj < 2; ++bj) *(u32x4*)(O + (size_t)(rbase + ai * HALF + m * 16) * ldc + col + bj * HALF) = pack8(acc[ai][bj][m][0], acc[ai][bj][m][1]);
    }
};
template <class Epi, class Sched, bool ALIGN_EPI = false, bool SP2 = false>
__device__ __forceinline__ void gemm_phase(PG8_LAS unsigned char* lds, const Gemm g, const Sched& S, const Epi& E) {
    int tid_ = threadIdx.x; asm volatile("" : "+v"(tid_));
    const int tid = tid_, wid = __builtin_amdgcn_readfirstlane(tid >> 6), lane = tid & 63, wr = wid >> 2, wc = wid & 3, fr = lane & 15, fq = lane >> 4;
    const int K = g.K, nt = K / BK;
    unsigned voffA[2], voffB[2];
#pragma unroll
    for (int i = 0; i < 2; ++i) { int R, C; stage_rc(tid * 16 + i * 8192, R, C); const int Rb = Epi::PERM ? ((R & ~31) + perm32(R & 31)) : R;
        voffA[i] = (unsigned)(R * K + C) * 2u; voffB[i] = (unsigned)(Rb * K + C) * 2u; }
    const size_t kstep = (size_t)(BK * 2);
    const size_t hstep = (size_t)HALF * K * 2;
    const size_t tstep = 2 * hstep;
    const unsigned ldsw = (unsigned)wid * 1024u;
    const int aoff = lds_byte(wr * 64 + fr, fq * 8), boff = lds_byte(wc * 32 + fr, fq * 8);
#define PG8_SA(b, h) (((b) * 2 + (h)) * HTB)
#define PG8_SB(b, h) ((4 + (b) * 2 + (h)) * HTB)
#define PG8_STAGE(bufoff, gbase, voff) do { _Pragma("unroll") for (int _i = 0; _i < 2; ++_i) \
        __builtin_amdgcn_global_load_lds((const unsigned*)((const char*)(gbase) + (voff)[_i]), (PG8_LAS unsigned*)(lds + (bufoff) + ldsw + _i * 8192), 16, 0, 0); } while (0)
#define PG8_LDA(dst, b, h) do { _Pragma("unroll") for (int m = 0; m < 4; ++m) _Pragma("unroll") for (int k = 0; k < 2; ++k) dst[m][k] = *(const PG8_LAS bf16x8*)(lds + PG8_SA(b, h) + aoff + m * 2048 + k * 1024); } while (0)
#define PG8_LDB(dst, b, h) do { _Pragma("unroll") for (int n = 0; n < 2; ++n) _Pragma("unroll") for (int k = 0; k < 2; ++k) dst[n][k] = *(const PG8_LAS bf16x8*)(lds + PG8_SB(b, h) + boff + n * 2048 + k * 1024); } while (0)
#define PG8_MMA(ai, bj, At, Bt) do { __builtin_amdgcn_s_setprio(1); _Pragma("unroll") for (int m = 0; m < 4; ++m) _Pragma("unroll") for (int n = 0; n < 2; ++n) _Pragma("unroll") for (int k = 0; k < 2; ++k) \
        acc[ai][bj][m][n] = __builtin_amdgcn_mfma_f32_16x16x32_bf16(Bt[n][k], At[m][k], acc[ai][bj][m][n], 0, 0, 0); __builtin_amdgcn_s_setprio(0); } while (0)
#define PG8_WAIT_V(n) asm volatile("s_waitcnt vmcnt(" #n ")" ::: "memory")
#define PG8_WAIT_L(n) asm volatile("s_waitcnt lgkmcnt(" #n ")" ::: "memory")
#define PG8_BAR __builtin_amdgcn_s_barrier()
#define PG8_SCHED __builtin_amdgcn_sched_barrier(0)
    Unit cur, nxt; int ui = 0;
    if (!S.next(0, cur)) return;
    f32x4 acc[2][2][4][2];
#pragma unroll
    for (int a = 0; a < 2; ++a)
#pragma unroll
        for (int b = 0; b < 2; ++b)
#pragma unroll
            for (int m = 0; m < 4; ++m)
#pragma unroll
                for (int n = 0; n < 2; ++n) acc[a][b][m][n] = (f32x4){0.f, 0.f, 0.f, 0.f};
    bf16x8 At[4][2], B0[2][2], B1[2][2];
    const char* cA = (const char*)g.A + (size_t)(cur.pm + cur.pn * g.apn) * tstep; const char* cB = (const char*)g.Bt + (size_t)cur.pn * tstep;
    S.a_ready(cur);
    if constexpr (SP2) {
        PG8_STAGE(PG8_SB(0, 0), cB, voffB); PG8_STAGE(PG8_SB(0, 1), cB + hstep, voffB); PG8_STAGE(PG8_SA(0, 0), cA, voffA); PG8_STAGE(PG8_SA(0, 1), cA + hstep, voffA);
        if (wr == 1) PG8_BAR;
        PG8_WAIT_V(2); PG8_BAR;
        PG8_STAGE(PG8_SB(1, 0), cB + kstep, voffB); PG8_STAGE(PG8_SA(1, 0), cA + kstep, voffA); PG8_STAGE(PG8_SB(1, 1), cB + hstep + kstep, voffB);
        PG8_WAIT_V(6); PG8_BAR;
    } else {
        PG8_STAGE(PG8_SB(0, 0), cB, voffB); PG8_STAGE(PG8_SA(0, 0), cA, voffA); PG8_STAGE(PG8_SB(0, 1), cB + hstep, voffB); PG8_STAGE(PG8_SA(0, 1), cA + hstep, voffA);
        if (wr == 1) PG8_BAR;
        PG8_WAIT_V(4); PG8_BAR;
        PG8_STAGE(PG8_SB(1, 0), cB + kstep, voffB); PG8_STAGE(PG8_SA(1, 0), cA + kstep, voffA); PG8_STAGE(PG8_SB(1, 1), cB + hstep + kstep, voffB);
        PG8_WAIT_V(6); PG8_BAR;
    }
    for (;;) {
        const bool has_next = S.next(ui + 1, nxt);
        const char* nA = has_next ? (const char*)g.A + (size_t)(nxt.pm + nxt.pn * g.apn) * tstep : cA; const char* nB = has_next ? (const char*)g.Bt + (size_t)nxt.pn * tstep : cB;
_Pragma("unroll 1")
        for (int t = 0; t < nt; t += 2) {
            const bool last = (t == nt - 2);
            const char* a1 = cA + (size_t)(t + 1) * kstep;
            const char* a2 = last ? nA : cA + (size_t)(t + 2) * kstep; const char* b2 = last ? nB : cB + (size_t)(t + 2) * kstep;
            const char* a3 = a2 + kstep; const char* b3 = b2 + kstep;
            if (last && has_next) S.a_ready(nxt);
            if constexpr (SP2) {
            PG8_LDB(B0, 0, 0); PG8_LDB(B1, 0, 1); PG8_SCHED; PG8_LDA(At, 0, 0); PG8_STAGE(PG8_SA(1, 1), a1 + hstep, voffA);
            PG8_WAIT_V(8); PG8_WAIT_L(0); PG8_BAR; PG8_MMA(0, 0, At, B0); PG8_MMA(0, 1, At, B1); PG8_BAR; PG8_SCHED;
            PG8_LDA(At, 0, 1); PG8_STAGE(PG8_SB(0, 0), b2, voffB); PG8_STAGE(PG8_SB(0, 1), b2 + hstep, voffB); PG8_STAGE(PG8_SA(0, 0), a2, voffA);
            PG8_WAIT_V(8); PG8_WAIT_L(0); PG8_BAR; PG8_MMA(1, 0, At, B0); PG8_MMA(1, 1, At, B1); PG8_BAR; PG8_SCHED;
            PG8_LDB(B0, 1, 0); PG8_LDB(B1, 1, 1); PG8_SCHED; PG8_LDA(At, 1, 0); PG8_STAGE(PG8_SA(0, 1), a2 + hstep, voffA);
            PG8_WAIT_V(8); PG8_WAIT_L(0); PG8_BAR; PG8_MMA(0, 0, At, B0); PG8_MMA(0, 1, At, B1); PG8_BAR; PG8_SCHED;
            PG8_LDA(At, 1, 1); PG8_STAGE(PG8_SB(1, 0), b3, voffB); PG8_STAGE(PG8_SB(1, 1), b3 + hstep, voffB); PG8_STAGE(PG8_SA(1, 0), a3, voffA);
            PG8_WAIT_V(8); PG8_WAIT_L(0); PG8_BAR; PG8_MMA(1, 0, At, B0); PG8_MMA(1, 1, At, B1); PG8_BAR; PG8_SCHED;
            } else {
            PG8_LDB(B0, 0, 0); PG8_SCHED; PG8_LDA(At, 0, 0); PG8_STAGE(PG8_SA(1, 1), a1 + hstep, voffA);
            PG8_WAIT_L(8); PG8_BAR; PG8_WAIT_L(0); PG8_MMA(0, 0, At, B0); PG8_BAR; PG8_SCHED;
            PG8_LDB(B1, 0, 1); PG8_STAGE(PG8_SB(0, 0), b2, voffB);
            PG8_BAR; PG8_WAIT_L(0); PG8_MMA(0, 1, At, B1); PG8_BAR;
            PG8_LDA(At, 0, 1); PG8_STAGE(PG8_SA(0, 0), a2, voffA);
            PG8_BAR; PG8_WAIT_L(0); PG8_MMA(1, 0, At, B0); PG8_BAR; PG8_SCHED;
            PG8_STAGE(PG8_SB(0, 1), b2 + hstep, voffB);
            PG8_WAIT_V(6); PG8_BAR; PG8_MMA(1, 1, At, B1); PG8_BAR;
            PG8_LDB(B0, 1, 0); PG8_SCHED; PG8_LDA(At, 1, 0); PG8_STAGE(PG8_SA(0, 1), a2 + hstep, voffA);
            PG8_WAIT_L(8); PG8_BAR; PG8_WAIT_L(0); PG8_MMA(0, 0, At, B0); PG8_BAR; PG8_SCHED;
            PG8_LDB(B1, 1, 1); PG8_STAGE(PG8_SB(1, 0), b3, voffB);
            PG8_BAR; PG8_WAIT_L(0); PG8_MMA(0, 1, At, B1); PG8_BAR;
            PG8_LDA(At, 1, 1); PG8_STAGE(PG8_SA(1, 0), a3, voffA);
            PG8_BAR; PG8_WAIT_L(0); PG8_MMA(1, 0, At, B0); PG8_BAR; PG8_SCHED;
            PG8_STAGE(PG8_SB(1, 1), b3 + hstep, voffB);
            PG8_WAIT_V(6); PG8_BAR; PG8_MMA(1, 1, At, B1); PG8_BAR;
            }
        }
        if constexpr (ALIGN_EPI) { if (wr == 0) PG8_BAR; }
        if constexpr (!Epi::AFTER_DRAIN) { E(acc, cur, wr, wc, fr, fq); S.done(cur); }
        if (!has_next) break;
#pragma unroll
        for (int a = 0; a < 2; ++a)
#pragma unroll
            for (int b = 0; b < 2; ++b)
#pragma unroll
                for (int m = 0; m < 4; ++m)
#pragma unroll
                    for (int n = 0; n < 2; ++n) acc[a][b][m][n] = (f32x4){0.f, 0.f, 0.f, 0.f};
        cur = nxt; cA = nA; cB = nB; ++ui;
        if constexpr (ALIGN_EPI) { if (wr == 1) PG8_BAR; }
    }
    PG8_WAIT_V(0);
    if constexpr (!ALIGN_EPI) { if (wr == 0) PG8_BAR; }
    PG8_BAR;
    if constexpr (Epi::AFTER_DRAIN) { E.fused(acc, cur, wr, wc, fr, fq, lds, wid, lane); S.done(cur); }
#undef PG8_SA
#undef PG8_SB
#undef PG8_STAGE
#undef PG8_LDA
#undef PG8_LDB
#undef PG8_MMA
#undef PG8_WAIT_V
#undef PG8_WAIT_L
#undef PG8_BAR
#undef PG8_SCHED
}
}
#define XB_TMO      128
#define XB_XCNT(j)  (256  + 64 * (j))
#define XB_XSUB(j)  (1280 + 64 * (j))
#define XB_XGEN(j)  (2304 + 64 * (j))
#define XB_TOP      3328
#define XB_TOPGEN   3392
#define XCD_BAR_WORDS 3456
#define XB_SPIN_CAP (1u << 18)

__device__ __forceinline__ unsigned xb_ld(unsigned* p)              { return __hip_atomic_load(p, __ATOMIC_RELAXED, __HIP_MEMORY_SCOPE_AGENT); }
__device__ __forceinline__ unsigned xb_add(unsigned* p, unsigned v) { return __hip_atomic_fetch_add(p, v, __ATOMIC_RELAXED, __HIP_MEMORY_SCOPE_AGENT); }
__device__ __forceinline__ unsigned xb_xcc_id() { return (unsigned)__builtin_amdgcn_s_getreg((3 << 11) | 20) & 0xFu; }
#define XB_SPIN(cond, bar) do { unsigned _sp = 0; while (cond) { __builtin_amdgcn_s_sleep(1); \
    if ((++_sp & 255u) == 0u) { if (xb_ld(&(bar)[XB_TMO])) break; if (_sp > XB_SPIN_CAP) { atomicAdd(&(bar)[XB_TMO], 1u); break; } } } } while (0)

struct XcdBarrier {
    unsigned* bar; unsigned x;
    volatile LAS unsigned* st;
};

__device__ __forceinline__ XcdBarrier xcd_barrier_post(unsigned* bar, volatile LAS unsigned* st) {
    XcdBarrier b; b.bar = bar; b.x = xb_xcc_id(); b.st = st;
    if (threadIdx.x == 0) (void)xb_add(&bar[XB_XCNT(b.x)], 1u);
    return b;
}
__device__ __forceinline__ void xcd_barrier_complete(unsigned* bar, unsigned x, unsigned& nloc, unsigned& nx) {
    const unsigned G = gridDim.x * gridDim.y * gridDim.z;
    unsigned sum, cnt, mine, sp = 0u;
    for (;;) {
        sum = 0u; cnt = 0u; mine = 0u;
#pragma unroll
        for (unsigned j = 0; j < 16; ++j) { const unsigned c = xb_ld(&bar[XB_XCNT(j)]); sum += c; cnt += (c > 0u) ? 1u : 0u; mine = (j == x) ? c : mine; }
        if (sum == G) break;
        __builtin_amdgcn_s_sleep(1);
        if ((++sp & 255u) == 0u) { if (xb_ld(&bar[XB_TMO])) break; if (sp > XB_SPIN_CAP) { atomicAdd(&bar[XB_TMO], 1u); break; } }
    }
    nloc = mine > 0u ? mine : 1u; nx = cnt > 0u ? cnt : 1u;
}

__device__ __forceinline__ void xcd_barrier(const XcdBarrier& b) {
    asm volatile("s_waitcnt vmcnt(0)" ::: "memory");
    __syncthreads();
    if (threadIdx.x == 0) {
        unsigned* bar = b.bar;
        __builtin_amdgcn_s_waitcnt(0);
        unsigned nloc = b.st[0], nx = b.st[1];
        if (nloc == 0u) { xcd_barrier_complete(bar, b.x, nloc, nx); b.st[0] = nloc; b.st[1] = nx; }
        const unsigned old = xb_add(&bar[XB_XSUB(b.x)], 1u);
        const unsigned gen = old / nloc;
        if (old + 1u == (gen + 1u) * nloc) {
            __builtin_amdgcn_fence(__ATOMIC_RELEASE, "agent");
            asm volatile("s_waitcnt vmcnt(0)" ::: "memory");
            const unsigned og = xb_add(&bar[XB_TOP], 1u);
            const unsigned tg = og / nx;
            if (og + 1u == (tg + 1u) * nx) xb_add(&bar[XB_TOPGEN], 1u);
            else XB_SPIN(xb_ld(&bar[XB_TOPGEN]) == tg, bar);
            __builtin_amdgcn_fence(__ATOMIC_ACQUIRE, "agent");
            xb_add(&bar[XB_XGEN(b.x)], 1u);
            asm volatile("s_waitcnt vmcnt(0)" ::: "memory");
        } else {
            XB_SPIN(xb_ld(&bar[XB_XGEN(b.x)]) == gen, bar);
            __builtin_amdgcn_fence(__ATOMIC_ACQUIRE, "agent");
            asm volatile("s_waitcnt vmcnt(0)" ::: "memory");
        }
    }
    __syncthreads();
}
using pg8::cvt_pk_bf16;
__device__ __forceinline__ float bflo(unsigned w) { return __uint_as_float(w << 16); }
__device__ __forceinline__ float bfhi(unsigned w) { return __uint_as_float(w & 0xffff0000u); }
__device__ __forceinline__ bf16x8 scale_frag8(const bf16x8 v, const float (&z)[8]) {
    const u32x4 w = __builtin_bit_cast(u32x4, v); u32x4 o;
    o.x = cvt_pk_bf16(bflo(w.x) * z[0], bfhi(w.x) * z[1]); o.y = cvt_pk_bf16(bflo(w.y) * z[2], bfhi(w.y) * z[3]);
    o.z = cvt_pk_bf16(bflo(w.z) * z[4], bfhi(w.z) * z[5]); o.w = cvt_pk_bf16(bflo(w.w) * z[6], bfhi(w.w) * z[7]);
    return __builtin_bit_cast(bf16x8, o);
}
__device__ __forceinline__ bf16x8 scale_frag1(const bf16x8 v, const float z) {
    const u32x4 w = __builtin_bit_cast(u32x4, v); u32x4 o;
    o.x = cvt_pk_bf16(bflo(w.x) * z, bfhi(w.x) * z); o.y = cvt_pk_bf16(bflo(w.y) * z, bfhi(w.y) * z);
    o.z = cvt_pk_bf16(bflo(w.z) * z, bfhi(w.z) * z); o.w = cvt_pk_bf16(bflo(w.w) * z, bfhi(w.w) * z);
    return __builtin_bit_cast(bf16x8, o);
}

#define BAR_LDS() do { asm volatile("s_waitcnt lgkmcnt(0)" ::: "memory"); __builtin_amdgcn_s_barrier(); asm volatile("" ::: "memory"); } while (0)
constexpr int KS = 288, VS = 272;
__device__ __forceinline__ void ld_tile4(u32x4 (&r)[4], const bf16_t* src, size_t row_elems, int tid) {
#pragma unroll
    for (int i = 0; i < 4; ++i) { const int p = tid + 512 * i; r[i] = *(const u32x4*)(src + (size_t)(p >> 4) * row_elems + (p & 15) * 8); }
}
__device__ __forceinline__ void st_tile4(LAS unsigned char* dst, int stride, const u32x4 (&r)[4], int tid) {
#pragma unroll
    for (int i = 0; i < 4; ++i) { const int p = tid + 512 * i; *(LAS u32x4*)(dst + (p >> 4) * stride + (p & 15) * 16) = r[i]; }
}

constexpr int SCAN_BUF = 128 * KS + 16 * KS;
__device__ __forceinline__ void scan_cu(LAS unsigned char* L, const bf16_t* KT, const bf16_t* VT, bf16_t* ST, int unit, int w, int lane, int tid) {
    const int bh = unit >> 4, dvs = unit & 15, h = bh & 7, fr = lane & 15, fq = lane >> 4;
    const float lg = log2f(1.0f - exp2f(-5.0f - (float)h));
    const float decay = exp2f(128.0f * lg);
    float z[4][8];
#pragma unroll
    for (int ks = 0; ks < 4; ++ks)
#pragma unroll
        for (int j = 0; j < 8; ++j) z[ks][j] = exp2f((float)(127 - (32 * ks + 8 * fq + j)) * lg);
    const bf16_t* ksrc = KT + (size_t)(bh * DK) * SEQ;
    const bf16_t* vsrc = VT + ((size_t)(bh * DV + dvs * 16) + (tid >> 4)) * SEQ + (tid & 15) * 8;
    bf16_t* st = ST + ((size_t)bh * NCH * DV + dvs * 16 + fr) * DK + 16 * w + 4 * fq;
    const bool vth = tid < 256;
    u32x4 qk[4][4], qv[4];
#pragma unroll
    for (int s = 0; s < 4; ++s) { ld_tile4(qk[s], ksrc + s * CHUNK, SEQ, tid); qv[s] = (u32x4){0u, 0u, 0u, 0u}; if (vth) qv[s] = *(const u32x4*)(vsrc + s * CHUNK); }
    f32x4 S = {0.f, 0.f, 0.f, 0.f};
#pragma unroll 1
    for (int n4 = 0; n4 < NCH; n4 += 4) {
#pragma unroll
        for (int s = 0; s < 4; ++s) {
            const int n = n4 + s;
            LAS unsigned char* buf = L + (s & 1) * SCAN_BUF;
            if (n < NCH - 1) {
                st_tile4(buf, KS, qk[s], tid);
                if (vth) *(LAS u32x4*)(buf + 128 * KS + (tid >> 4) * KS + (tid & 15) * 16) = qv[s];
                if (n + 4 < NCH - 1) { ld_tile4(qk[s], ksrc + (n + 4) * CHUNK, SEQ, tid); if (vth) qv[s] = *(const u32x4*)(vsrc + (n + 4) * CHUNK); }
                BAR_LDS();
            }
            u32x2 wv; wv.x = cvt_pk_bf16(S[0], S[1]); wv.y = cvt_pk_bf16(S[2], S[3]);
            *(u32x2*)(st + (size_t)n * DV * DK) = wv;
            if (n < NCH - 1) {
                f32x4 kv = {0.f, 0.f, 0.f, 0.f};
#pragma unroll
                for (int ks = 0; ks < 4; ++ks) { const bf16x8 a = *(const LAS bf16x8*)(buf + (16 * w + fr) * KS + 64 * ks + 16 * fq), b = *(const LAS bf16x8*)(buf + 128 * KS + fr * KS + 64 * ks + 16 * fq);
                    kv = __builtin_amdgcn_mfma_f32_16x16x32_bf16(a, scale_frag8(b, z[ks]), kv, 0, 0, 0); }
                S = S * decay + kv;
            }
        }
    }
    BAR_LDS();
}

__device__ __forceinline__ void acc8(float (&s)[8], const u32x4 v, const float sg) {
    s[0] += sg * bflo(v.x); s[1] += sg * bfhi(v.x); s[2] += sg * bflo(v.y); s[3] += sg * bfhi(v.y); s[4] += sg * bflo(v.z); s[5] += sg * bfhi(v.z); s[6] += sg * bflo(v.w); s[7] += sg * bfhi(v.w); }
template <int W> __device__ __forceinline__ void pooled_item(const bf16_t* U, bf16_t* PO, int g, int run, int lane) {
    const int sub = lane >> 5, oct = lane & 31, t0 = run * 16 + sub * 8, tb0 = t0 & (SEQ - 1);
    const bf16_t* up = U + (size_t)t0 * PW + g * PGD + oct * 8;
    u32x4 u[W + 7];
#pragma unroll
    for (int i = 0; i < W + 7; ++i) { const int d = i - (W - 1); u[i] = (u32x4){0u, 0u, 0u, 0u}; if (tb0 + d >= 0) u[i] = *(const u32x4*)(up + (ptrdiff_t)d * PW); }
    float sum[8];
#pragma unroll
    for (int e = 0; e < 8; ++e) sum[e] = 0.f;
#pragma unroll
    for (int i = 0; i < W - 1; ++i) acc8(sum, u[i], 1.0f);
    bf16_t* po = PO + ((size_t)g * M + t0) * PGD + oct * 8;
#pragma unroll
    for (int o = 0; o < 8; ++o) {
        const u32x4 cu = u[W - 1 + o];
        acc8(sum, cu, 1.0f);
        if (o >= 1) acc8(sum, u[o - 1], -1.0f);
        const float cnt = (float)((tb0 + o + 1 < W) ? tb0 + o + 1 : W);
        u32x4 w; w.x = cvt_pk_bf16(sum[0] / cnt - bflo(cu.x), sum[1] / cnt - bfhi(cu.x)); w.y = cvt_pk_bf16(sum[2] / cnt - bflo(cu.y), sum[3] / cnt - bfhi(cu.y));
        w.z = cvt_pk_bf16(sum[4] / cnt - bflo(cu.z), sum[5] / cnt - bfhi(cu.z)); w.w = cvt_pk_bf16(sum[6] / cnt - bflo(cu.w), sum[7] / cnt - bfhi(cu.w));
        *(u32x4*)(po + (size_t)o * PGD) = w;
    }
}

template <int HALF_> __device__ __forceinline__ void retout_half(f32x4 (&acc)[16], const LAS unsigned char* LV, const LAS unsigned char* LS, const unsigned (&pk)[8][2], const bf16x8 (&qx)[4], int w, int fr, int fq) {
#pragma unroll
    for (int kk = 0; kk < 4; ++kk) if (2 * kk <= w) {
        u32x4 bw; bw.x = pk[2 * kk][0]; bw.y = pk[2 * kk][1]; bw.z = pk[2 * kk + 1][0]; bw.w = pk[2 * kk + 1][1];
        const bf16x8 bfrag = __builtin_bit_cast(bf16x8, bw);
#pragma unroll
        for (int d = 0; d < 8; ++d) { const LAS unsigned char* p = LV + (16 * d + fr) * VS + 64 * kk + 8 * fq;
            const u32x2 lo = *(const LAS u32x2*)p, hi = *(const LAS u32x2*)(p + 32);
            u32x4 aw; aw.x = lo.x; aw.y = lo.y; aw.z = hi.x; aw.w = hi.y;
            acc[8 * HALF_ + d] = __builtin_amdgcn_mfma_f32_16x16x32_bf16(__builtin_bit_cast(bf16x8, aw), bfrag, acc[8 * HALF_ + d], 0, 0, 0); }
    }
#pragma unroll
    for (int ks = 0; ks < 4; ++ks)
#pragma unroll
        for (int d = 0; d < 8; ++d) acc[8 * HALF_ + d] = __builtin_amdgcn_mfma_f32_16x16x32_bf16(*(const LAS bf16x8*)(LS + (16 * d + fr) * KS + 64 * ks + 16 * fq), qx[ks], acc[8 * HALF_ + d], 0, 0, 0);
}
__device__ __forceinline__ void retout_cu(LAS unsigned char* L, const bf16_t* Q, const bf16_t* Kb, const bf16_t* VT, const bf16_t* ST, const bf16_t* GR, bf16_t* YR, int vcu, int G, int w, int lane, int tid) {
    LAS unsigned char* LK = L; LAS unsigned char* LV = L + 128 * KS; LAS unsigned char* LS = LV + 128 * VS;
    const int fr = lane & 15, fq = lane >> 4, c = 16 * w + fr;
#pragma unroll 1
    for (int unit = vcu; unit < NB * HEADS * NCH; unit += G) {
        const int bh = unit >> 5, n = unit & 31, b = bh >> 3, h = bh & 7;
        const float lg = log2f(1.0f - exp2f(-5.0f - (float)h));
        const int tok0 = b * SEQ + n * CHUNK, s0 = n * CHUNK;
        const bf16_t* vsrc = VT + (size_t)(bh * DV) * SEQ + s0; const bf16_t* ssrc = ST + (size_t)(bh * NCH + n) * DV * DK;
        u32x4 rk[4], rv[4], rs[4];
        ld_tile4(rk, Kb + (size_t)tok0 * QKW + h * DK, QKW, tid); ld_tile4(rv, vsrc, SEQ, tid); ld_tile4(rs, ssrc, DK, tid);
        bf16x8 qf[4];
        { const bf16_t* qp = Q + (size_t)(tok0 + c) * QKW + h * DK + 8 * fq;
#pragma unroll
          for (int ks = 0; ks < 4; ++ks) qf[ks] = *(const bf16x8*)(qp + 32 * ks); }
        st_tile4(LK, KS, rk, tid); st_tile4(LV, VS, rv, tid); st_tile4(LS, KS, rs, tid);
        BAR_LDS();
        ld_tile4(rv, vsrc + (size_t)128 * SEQ, SEQ, tid); ld_tile4(rs, ssrc + 128 * DK, DK, tid);
        unsigned pk[8][2];
#pragma unroll
        for (int mb = 0; mb < 8; ++mb) { pk[mb][0] = 0u; pk[mb][1] = 0u; }
#pragma unroll
        for (int mb = 0; mb < 8; ++mb) if (mb <= w) {
            f32x4 s = {0.f, 0.f, 0.f, 0.f};
#pragma unroll
            for (int ks = 0; ks < 4; ++ks) s = __builtin_amdgcn_mfma_f32_16x16x32_bf16(*(const LAS bf16x8*)(LK + (16 * mb + fr) * KS + 64 * ks + 16 * fq), qf[ks], s, 0, 0, 0);
            float p[4];
#pragma unroll
            for (int r = 0; r < 4; ++r) { const int e = c - (16 * mb + 4 * fq + r); p[r] = e >= 0 ? s[r] * exp2f((float)e * lg) : 0.f; }
            pk[mb][0] = cvt_pk_bf16(p[0], p[1]); pk[mb][1] = cvt_pk_bf16(p[2], p[3]);
        }
        const float xi = exp2f((float)(c + 1) * lg);
        bf16x8 qx[4];
#pragma unroll
        for (int ks = 0; ks < 4; ++ks) qx[ks] = scale_frag1(qf[ks], xi);
        f32x4 acc[16];
#pragma unroll
        for (int d = 0; d < 16; ++d) acc[d] = (f32x4){0.f, 0.f, 0.f, 0.f};
        retout_half<0>(acc, LV, LS, pk, qx, w, fr, fq);
        BAR_LDS();
        st_tile4(LV, VS, rv, tid); st_tile4(LS, KS, rs, tid);
        BAR_LDS();
        retout_half<1>(acc, LV, LS, pk, qx, w, fr, fq);
        float ss = 0.f;
#pragma unroll
        for (int d = 0; d < 16; ++d) ss += (acc[d][0] * acc[d][0] + acc[d][1] * acc[d][1]) + (acc[d][2] * acc[d][2] + acc[d][3] * acc[d][3]);
        ss += __shfl_xor(ss, 16); ss += __shfl_xor(ss, 32);
        const float rinv = rsqrtf(ss * (1.0f / DV) + NORM_EPS);
        const size_t ob = (size_t)(tok0 + c) * VW + h * DV + 4 * fq;
#pragma unroll
        for (int d = 0; d < 16; ++d) { const u32x2 g = *(const u32x2*)(GR + ob + 16 * d);
            u32x2 o; o.x = cvt_pk_bf16(acc[d][0] * rinv * bflo(g.x), acc[d][1] * rinv * bfhi(g.x)); o.y = cvt_pk_bf16(acc[d][2] * rinv * bflo(g.y), acc[d][3] * rinv * bfhi(g.y));
            *(u32x2*)(YR + ob + 16 * d) = o; }
        BAR_LDS();
    }
}

constexpr int NWAVES = 8, RING_BYTES = 131072, LDS_BYTES = 147456, MISC_OFF = LDS_BYTES - 256;
static_assert(NWAVES * TR_SCR_BYTES <= MISC_OFF, "prologue scratch below the control words");
constexpr int NPH_L = 9, NPHASES = 1 + DEPTH * NPH_L;
struct Args { const float* in[13]; float* out; unsigned char* ws; int ph_lo, ph_hi, li, pad; };

__global__ void __launch_bounds__(NWAVES * 64, 2) fwd(Args args) {
    extern __shared__ __attribute__((aligned(16))) unsigned char lds[];
    LAS unsigned char* L = (LAS unsigned char*)lds;
    const int tid = threadIdx.x, lane = tid & 63, wave = __builtin_amdgcn_readfirstlane(tid >> 6);
    const int G = gridDim.x, bx = blockIdx.x, vcu = (G % 8 == 0) ? (bx % 8) * (G / 8) + bx / 8 : bx;
    const int gw = vcu * NWAVES + wave, NGW = G * NWAVES;
    for (int u = tid; u < (LDS_BYTES - RING_BYTES) / 4; u += NWAVES * 64) ((LAS unsigned*)(L + RING_BYTES))[u] = 0u;
    __syncthreads();
    const int lo = args.ph_lo, hi = args.ph_hi;
    unsigned char* const ws0 = args.ws;
    unsigned* barw = (unsigned*)(ws0 + WS_CTL) + CW_BAR + args.li * XCD_BAR_WORDS;
    XcdBarrier bar; bar.bar = barw; bar.x = 0; bar.st = nullptr;
    if (hi - lo > 1) bar = xcd_barrier_post(barw, (volatile LAS unsigned*)(L + MISC_OFF) + 8);
#define IN(k) (lo <= (k) && (k) < hi)
#define TAIL_CONVERT(nwg_, ll, i0, i1) do { const int ext_ = (nwg_) % G, nt_ = ext_ ? G - ext_ : G, me_ = ext_ ? bx - ext_ : bx; \
        if (me_ >= 0) { int lane_ = lane; asm volatile("" : "+v"(lane_)); LAS float* scr_ = (LAS float*)(L + wave * TR_SCR_BYTES); \
            for (int it_ = (i0) + me_ * NWAVES + wave; it_ < (i1); it_ += nt_ * NWAVES) convert_item(args.in, ws, scr_, (ll), it_, lane_); } } while (0)
#define REPS(p) (1 + ((MK_REPEAT_MASK >> (p)) & 1))
#define SEAM(k) do { if (IN(k) && IN((k) + 1)) xcd_barrier(bar); } while (0)
#define WSP size_t wso_ = 0; asm volatile("" : "+s"(wso_)); unsigned char* ws = ws0 + wso_
#define BUFS bf16_t* XN = (bf16_t*)(ws + WS_XN); float* X = (float*)(ws + WS_X); bf16_t *Qb = (bf16_t*)(ws + WS_Q), *Kb = (bf16_t*)(ws + WS_K), *KT = (bf16_t*)(ws + WS_KT), *VT = (bf16_t*)(ws + WS_VT), *GR = (bf16_t*)(ws + WS_GR), *Ub = (bf16_t*)(ws + WS_U), \
           *Gb = (bf16_t*)(ws + WS_G), *ST = (bf16_t*)(ws + WS_ST), *PO = (bf16_t*)(ws + WS_PO), *YP = (bf16_t*)(ws + WS_YP), *YR = (bf16_t*)(ws + WS_YR), *MG = (bf16_t*)(ws + WS_MG), *Hb = (bf16_t*)(ws + WS_H); bf16_t* T1 = (bf16_t*)(ws + WS_T1); \
           (void)XN; (void)X; (void)Qb; (void)Kb; (void)KT; (void)VT; (void)GR; (void)Ub; (void)Gb; (void)ST; (void)PO; (void)YP; (void)YR; (void)MG; (void)Hb; (void)T1
    if (IN(0)) for (int rep = 0; rep < REPS(9); ++rep) { if (rep) xcd_barrier(bar);
        WSP; BUFS;
        int lane_ = lane; asm volatile("" : "+v"(lane_)); const int lane = lane_;
        LAS float* scr = (LAS float*)(L + wave * TR_SCR_BYTES);
#if MK_CONVERT_UPFRONT
        for (int it = gw; it < DEPTH * I_PER; it += NGW) convert_item(args.in, ws, scr, it / I_PER, it % I_PER, lane);
#else
        for (int it = gw; it < I_SETA; it += NGW) convert_item(args.in, ws, scr, 0, it, lane);
#endif
        for (int idx = gw * 64 + lane; idx < M * 64; idx += NGW * 64) trig_item((const int*)args.in[1], (float*)(ws + WS_TRIG), idx);
        for (int m = gw; m < M; m += NGW) rmsnorm_row(args.in[0] + (size_t)m * D, args.in[2], XN + (size_t)m * D, nullptr, lane);
    }
    SEAM(0);
    for (int l = 0; l < DEPTH; ++l) {
        const int pb = 1 + l * NPH_L;
        if (hi <= pb || lo >= pb + NPH_L) continue;
        if (IN(pb)) for (int rep = 0; rep < REPS(0); ++rep) { if (rep) xcd_barrier(bar);
            WSP; BUFS; unsigned char* wl = ws + WS_W + (size_t)l * W_STRIDE; (void)wl;
            pg8::Gemm g{XN, (const bf16_t*)(wl + WO_IN), M, INW, D, 0}; pg8::StaticOrder S; S.init(M, INW, G, bx);
            pg8::EpiIn E{Qb, Kb, KT, VT, GR, Ub, Gb, (const float*)(ws + WS_TRIG)};
            pg8::gemm_phase<pg8::EpiIn, pg8::StaticOrder, true, true>(L, g, S, E);
#if !MK_CONVERT_UPFRONT
            if (rep == 0) TAIL_CONVERT((M / 256) * (INW / 256), l, I_SETA, I_PER);
#endif
        }
        SEAM(pb);
        if (IN(pb + 1)) for (int rep = 0; rep < REPS(1); ++rep) { if (rep) xcd_barrier(bar);
            WSP; BUFS; unsigned char* wl = ws + WS_W + (size_t)l * W_STRIDE; (void)wl;
            int lane_ = lane; asm volatile("" : "+v"(lane_)); const int lane = lane_;
            { int tid_ = tid; asm volatile("" : "+v"(tid_)); for (int u = vcu; u < NB * HEADS * 16; u += G) scan_cu(L, KT, VT, ST, u, wave, lane, tid_); }
            for (int it = gw; it < PG * (M / 16); it += NGW) { const int g = it / (M / 16), run = it % (M / 16);
                if (g == 0) pooled_item<2>(Ub, PO, 0, run, lane); else if (g == 1) pooled_item<4>(Ub, PO, 1, run, lane); else if (g == 2) pooled_item<8>(Ub, PO, 2, run, lane); else pooled_item<16>(Ub, PO, 3, run, lane); }
        }
        SEAM(pb + 1);
        if (IN(pb + 2)) for (int rep = 0; rep < REPS(2); ++rep) { if (rep) xcd_barrier(bar);
            WSP; BUFS; unsigned char* wl = ws + WS_W + (size_t)l * W_STRIDE; (void)wl;
            { int lane_ = lane, tid_ = tid; asm volatile("" : "+v"(lane_), "+v"(tid_));
              retout_cu(L, Qb, Kb, VT, ST, GR, YR, vcu, G, wave, lane_, tid_); }
            pg8::Gemm g{PO, (const bf16_t*)(wl + WO_PM), M, PW, PGD, M / 256}; pg8::StaticOrder S; S.init(M, PW, G, bx);
            pg8::EpiPlain E{YP, PW};
            pg8::gemm_phase<pg8::EpiPlain, pg8::StaticOrder, true, true>(L, g, S, E);
        }
        SEAM(pb + 2);
        if (IN(pb + 3)) for (int rep = 0; rep < REPS(3); ++rep) { if (rep) xcd_barrier(bar);
            WSP; BUFS; unsigned char* wl = ws + WS_W + (size_t)l * W_STRIDE; (void)wl;
            { pg8::Gemm g{YR, (const bf16_t*)(wl + WO_RU), M, D, VW, 0}; pg8::StaticOrder S; S.init(M, D, G, bx); pg8::EpiT1 E{Gb, T1};
              pg8::gemm_phase<pg8::EpiT1, pg8::StaticOrder, true, true>(L, g, S, E); }
            { pg8::Gemm g{YP, (const bf16_t*)(wl + WO_PU), M, D, PW, 0}; pg8::StaticOrder S; S.init(M, D, G, bx); pg8::EpiMG E{Gb, T1, MG};
              pg8::gemm_phase<pg8::EpiMG, pg8::StaticOrder, true, true>(L, g, S, E); }
        }
        SEAM(pb + 3);
        if (IN(pb + 4)) for (int rep = 0; rep < REPS(4); ++rep) { if (rep) xcd_barrier(bar);
            WSP; BUFS; unsigned char* wl = ws + WS_W + (size_t)l * W_STRIDE; (void)wl;
            pg8::Gemm g{MG, (const bf16_t*)(wl + WO_O), M, D, D, 0}; pg8::StaticOrder S; S.init(M, D, G, bx); pg8::EpiResid E{l == 0 ? args.in[0] : X, rep ? (float*)T1 : X};
            pg8::gemm_phase<pg8::EpiResid, pg8::StaticOrder, true, true>(L, g, S, E);
        }
        SEAM(pb + 4);
        if (IN(pb + 5)) for (int rep = 0; rep < REPS(5); ++rep) { if (rep) xcd_barrier(bar);
            WSP; BUFS; unsigned char* wl = ws + WS_W + (size_t)l * W_STRIDE; (void)wl; int lane_ = lane; asm volatile("" : "+v"(lane_)); const int lane = lane_; for (int m = gw; m < M; m += NGW) rmsnorm_row(X + (size_t)m * D, args.in[9] + (size_t)l * D, XN + (size_t)m * D, nullptr, lane); }
        SEAM(pb + 5);
        if (IN(pb + 6)) for (int rep = 0; rep < REPS(6); ++rep) { if (rep) xcd_barrier(bar);
            WSP; BUFS; unsigned char* wl = ws + WS_W + (size_t)l * W_STRIDE; (void)wl;
            pg8::Gemm g{XN, (const bf16_t*)(wl + WO_GU), M, GUW, D, 0}; pg8::StaticOrder S; S.init(M, GUW, G, bx); pg8::EpiGU E{Hb};
            pg8::gemm_phase<pg8::EpiGU, pg8::StaticOrder, true, true>(L, g, S, E);
#if !MK_CONVERT_UPFRONT
            if (rep == 0 && l + 1 < DEPTH) TAIL_CONVERT((M / 256) * (GUW / 256), l + 1, 0, I_SETA);
#endif
        }
        SEAM(pb + 6);
        if (IN(pb + 7)) for (int rep = 0; rep < REPS(7); ++rep) { if (rep) xcd_barrier(bar);
            WSP; BUFS; unsigned char* wl = ws + WS_W + (size_t)l * W_STRIDE; (void)wl;
            pg8::Gemm g{Hb, (const bf16_t*)(wl + WO_D), M, D, DFF, 0}; pg8::StaticOrder S; S.init(M, D, G, bx); pg8::EpiResid E{X, rep ? (float*)T1 : X};
            pg8::gemm_phase<pg8::EpiResid, pg8::StaticOrder, true, true>(L, g, S, E);
        }
        SEAM(pb + 7);
        if (IN(pb + 8)) for (int rep = 0; rep < REPS(8); ++rep) { if (rep) xcd_barrier(bar);
            WSP; BUFS; unsigned char* wl = ws + WS_W + (size_t)l * W_STRIDE; (void)wl;
            int lane_ = lane; asm volatile("" : "+v"(lane_)); const int lane = lane_;
            if (l + 1 < DEPTH) { for (int m = gw; m < M; m += NGW) rmsnorm_row(X + (size_t)m * D, args.in[2] + (size_t)(l + 1) * D, XN + (size_t)m * D, nullptr, lane); }
            else { for (int m = gw; m < M; m += NGW) rmsnorm_row(X + (size_t)m * D, args.in[12], nullptr, args.out + (size_t)m * D, lane); }
        }
        SEAM(pb + 8);
    }
#undef IN
#undef SEAM
}
#if MK_NAIVE_MASK
struct Ptrs { const float* in[13]; float* out; unsigned char* ws; };
__global__ __launch_bounds__(256) void k_prologue_naive(Ptrs P) {
    __shared__ float scr_all[4][64 * 65];
    const int lane = threadIdx.x & 63, wave = threadIdx.x >> 6, gw = blockIdx.x * 4 + wave, NGW = gridDim.x * 4;
    LAS float* scr = (LAS float*)&scr_all[wave][0];
    for (int it = gw; it < DEPTH * I_PER; it += NGW) convert_item(P.in, P.ws, scr, it / I_PER, it % I_PER, lane);
    for (int idx = gw * 64 + lane; idx < M * 64; idx += NGW * 64) trig_item((const int*)P.in[1], (float*)(P.ws + WS_TRIG), idx);
}
__global__ __launch_bounds__(256) void k_rmsnorm(const float* x, const float* g, bf16_t* xn, float* fout) {
    const int lane = threadIdx.x & 63, gw = blockIdx.x * 4 + (threadIdx.x >> 6), NGW = gridDim.x * 4;
    for (int m = gw; m < M; m += NGW) rmsnorm_row(x + (size_t)m * D, g, xn ? xn + (size_t)m * D : nullptr, fout ? fout + (size_t)m * D : nullptr, lane);
}
__global__ __launch_bounds__(256) void k_gemm_naive(const bf16_t* A, int lda, const bf16_t* Bt, int ldb, float* C, int ldc, int K) {
    const int wave = threadIdx.x >> 6, lane = threadIdx.x & 63, fr = lane & 15, fq = lane >> 4;
    const int row0 = blockIdx.y * 128 + (wave >> 1) * 64, col0 = blockIdx.x * 128 + (wave & 1) * 64;
    f32x4 acc[4][4];
#pragma unroll
    for (int i = 0; i < 4; ++i)
#pragma unroll
        for (int j = 0; j < 4; ++j) acc[i][j] = (f32x4){0.f, 0.f, 0.f, 0.f};
    for (int k0 = 0; k0 < K; k0 += 32) {
        bf16x8 a[4], b[4];
#pragma unroll
        for (int i = 0; i < 4; ++i) a[i] = *(const bf16x8*)(A + (size_t)(row0 + 16 * i + fr) * lda + k0 + 8 * fq);
#pragma unroll
        for (int j = 0; j < 4; ++j) b[j] = *(const bf16x8*)(Bt + (size_t)(col0 + 16 * j + fr) * ldb + k0 + 8 * fq);
#pragma unroll
        for (int i = 0; i < 4; ++i)
#pragma unroll
            for (int j = 0; j < 4; ++j) acc[i][j] = __builtin_amdgcn_mfma_f32_16x16x32_bf16(a[i], b[j], acc[i][j], 0, 0, 0);
    }
#pragma unroll
    for (int i = 0; i < 4; ++i)
#pragma unroll
        for (int j = 0; j < 4; ++j)
#pragma unroll
            for (int r = 0; r < 4; ++r) C[(size_t)(row0 + 16 * i + 4 * fq + r) * ldc + col0 + 16 * j + fr] = acc[i][j][r];
}
__global__ void k_post_in(Ptrs P) {
    const size_t idx = (size_t)blockIdx.x * blockDim.x + threadIdx.x; if (idx >= (size_t)M * INW) return;
    const int r = (int)(idx / INW), n = (int)(idx % INW), b = r / SEQ, s = r % SEQ;
    const float* proj = (const float*)(P.ws + WS_TMP) + (size_t)r * INW;
    unsigned char* ws = P.ws;
    if (n < 2 * QKW) {
        const int sec = n / QKW, w = n % QKW, tile = w / 256, p = (w % 256) / 128, hl = (w % 128) / 64, i = w % 64; if (p) return;
        const int head = 2 * tile + hl; const float x1 = proj[n], x2 = proj[n + 128];
        const float* T = (const float*)(ws + WS_TRIG) + ((size_t)r * 64 + i) * 2; const float c = T[0], sn = T[1];
        float o1 = x1 * c - x2 * sn, o2 = x2 * c + x1 * sn;
        if (sec == 0) { o1 *= Q_SCALE; o2 *= Q_SCALE; bf16_t* Q = (bf16_t*)(ws + WS_Q) + (size_t)r * QKW + head * DK; Q[i] = f2bf(o1); Q[64 + i] = f2bf(o2); }
        else { bf16_t* Kb = (bf16_t*)(ws + WS_K) + (size_t)r * QKW + head * DK; Kb[i] = f2bf(o1); Kb[64 + i] = f2bf(o2);
               bf16_t* KT = (bf16_t*)(ws + WS_KT) + ((size_t)(b * HEADS + head) * DK) * SEQ + s; KT[(size_t)i * SEQ] = f2bf(o1); KT[(size_t)(64 + i) * SEQ] = f2bf(o2); }
    } else if (n < 2 * QKW + VW) { const int vc = n - 2 * QKW, head = vc / DV, dv = vc % DV;
        ((bf16_t*)(ws + WS_VT))[((size_t)(b * HEADS + head) * DV + dv) * SEQ + s] = f2bf(proj[n]);
    } else if (n < 2 * QKW + 2 * VW) { ((bf16_t*)(ws + WS_GR))[(size_t)r * VW + (n - 2 * QKW - VW)] = f2bf(silu_f(proj[n]));
    } else if (n < 2 * QKW + 2 * VW + PW) { ((bf16_t*)(ws + WS_U))[(size_t)r * PW + (n - 2 * QKW - 2 * VW)] = f2bf(proj[n]);
    } else { ((bf16_t*)(ws + WS_G))[(size_t)r * 2 * D + (n - 2 * QKW - 2 * VW - PW)] = f2bf(sigmoid_f(proj[n])); }
}
__global__ __launch_bounds__(256) void k_ret_naive(Ptrs P) {
    const int bh = blockIdx.x, b = bh >> 3, h = bh & 7, dv = threadIdx.x, lane = dv & 63, wave = dv >> 6;
    const bf16_t* Q = (const bf16_t*)(P.ws + WS_Q); const bf16_t* Kb = (const bf16_t*)(P.ws + WS_K); const bf16_t* VT = (const bf16_t*)(P.ws + WS_VT);
    const bf16_t* GR = (const bf16_t*)(P.ws + WS_GR); bf16_t* YR = (bf16_t*)(P.ws + WS_YR);
    const float gamma = 1.0f - exp2f(-5.0f - (float)h);
    float Sx[DK];
#pragma unroll
    for (int d = 0; d < DK; ++d) Sx[d] = 0.f;
    __shared__ float qs[DK], ks[DK], red[4];
    for (int s = 0; s < SEQ; ++s) {
        const size_t token = (size_t)b * SEQ + s;
        if (dv < DK) { qs[dv] = bf2f(Q[token * QKW + h * DK + dv]); ks[dv] = bf2f(Kb[token * QKW + h * DK + dv]); }
        const float v = bf2f(VT[((size_t)bh * DV + dv) * SEQ + s]);
        __syncthreads();
        float y = 0.f;
#pragma unroll
        for (int d = 0; d < DK; ++d) { Sx[d] = gamma * Sx[d] + ks[d] * v; y += qs[d] * Sx[d]; }
        const float ss = wave_sum(y * y);
        if (lane == 0) red[wave] = ss;
        __syncthreads();
        const float tot = (red[0] + red[1]) + (red[2] + red[3]);
        const float yn = y * rsqrtf(tot * (1.0f / DV) + NORM_EPS);
        YR[token * VW + h * DV + dv] = f2bf(yn * bf2f(GR[token * VW + h * DV + dv]));
        __syncthreads();
    }
}
__global__ void k_pooled_naive(Ptrs P) {
    const int idx = blockIdx.x * blockDim.x + threadIdx.x; if (idx >= M * PW) return;
    const int r = idx / PW, col = idx % PW, g = col / PGD, c = col % PGD, w = 2 << g, tb = r % SEQ;
    const bf16_t* U = (const bf16_t*)(P.ws + WS_U);
    const int cnt = (tb + 1 < w) ? tb + 1 : w; float sum = 0.f;
    for (int j = 0; j < cnt; ++j) sum += bf2f(U[(size_t)(r - j) * PW + col]);
    ((bf16_t*)(P.ws + WS_PO))[((size_t)g * M + r) * PGD + c] = f2bf(sum / (float)cnt - bf2f(U[(size_t)r * PW + col]));
}
__global__ void k_f32_to_bf16(const float* in, bf16_t* out, size_t n) { const size_t i = (size_t)blockIdx.x * blockDim.x + threadIdx.x; if (i < n) out[i] = f2bf(in[i]); }
__global__ void k_merge(Ptrs P) {
    const size_t i = (size_t)blockIdx.x * blockDim.x + threadIdx.x; if (i >= (size_t)M * D) return;
    const size_t r = i / D, c = i % D; const float* tmp = (const float*)(P.ws + WS_TMP); const bf16_t* G = (const bf16_t*)(P.ws + WS_G);
    ((bf16_t*)(P.ws + WS_MG))[i] = f2bf(bf2f(G[r * 2 * D + c]) * tmp[i] + bf2f(G[r * 2 * D + D + c]) * tmp[(size_t)M * D + i]);
}
__global__ void k_resid(const float* base, const float* add, float* out, size_t n) { const size_t i = (size_t)blockIdx.x * blockDim.x + threadIdx.x; if (i < n) out[i] = base[i] + add[i]; }
__global__ void k_swiglu(Ptrs P) {
    const size_t i = (size_t)blockIdx.x * blockDim.x + threadIdx.x; if (i >= (size_t)M * DFF) return;
    const size_t r = i / DFF; const int j = (int)(i % DFF), tile = j / 128, jj = j % 128; const float* t = (const float*)(P.ws + WS_TMP) + r * GUW + tile * 256;
    ((bf16_t*)(P.ws + WS_H))[i] = f2bf(silu_f(t[jj]) * t[128 + jj]);
}
static void gemm_naive(hipStream_t st, const bf16_t* A, int lda, const bf16_t* Bt, int ldb, float* C, int ldc, int Mr, int N, int K) {
    hipLaunchKernelGGL(k_gemm_naive, dim3(N / 128, Mr / 128), dim3(256), 0, st, A, lda, Bt, ldb, C, ldc, K);
}
static void naive_stage(hipStream_t stream, const Ptrs& P, int l, int p) {
    unsigned char* ws = P.ws; unsigned char* wl = ws + WS_W + (size_t)l * W_STRIDE;
    float* X = (float*)(ws + WS_X); bf16_t* XN = (bf16_t*)(ws + WS_XN); float* TMP = (float*)(ws + WS_TMP);
    const float* xin = l == 0 ? P.in[0] : X;
    switch (p) {
    case 0: gemm_naive(stream, XN, D, (const bf16_t*)(wl + WO_IN), D, TMP, INW, M, INW, D);
            hipLaunchKernelGGL(k_post_in, dim3((unsigned)(((size_t)M * INW + 255) / 256)), dim3(256), 0, stream, P); break;
    case 1: hipLaunchKernelGGL(k_pooled_naive, dim3(M * PW / 256), dim3(256), 0, stream, P); break;
    case 2: hipLaunchKernelGGL(k_ret_naive, dim3(NB * HEADS), dim3(256), 0, stream, P);
            for (int g = 0; g < PG; ++g) gemm_naive(stream, (const bf16_t*)(ws + WS_PO) + (size_t)g * M * PGD, PGD, (const bf16_t*)(wl + WO_PM) + (size_t)g * PGD * PGD, PGD, TMP + g * PGD, PW, M, PGD, PGD);
            hipLaunchKernelGGL(k_f32_to_bf16, dim3(M * PW / 256), dim3(256), 0, stream, (const float*)TMP, (bf16_t*)(ws + WS_YP), (size_t)M * PW); break;
    case 3: gemm_naive(stream, (const bf16_t*)(ws + WS_YR), VW, (const bf16_t*)(wl + WO_RU), VW, TMP, D, M, D, VW);
            gemm_naive(stream, (const bf16_t*)(ws + WS_YP), PW, (const bf16_t*)(wl + WO_PU), PW, TMP + (size_t)M * D, D, M, D, PW);
            hipLaunchKernelGGL(k_merge, dim3(M * D / 256), dim3(256), 0, stream, P); break;
    case 4: gemm_naive(stream, (const bf16_t*)(ws + WS_MG), D, (const bf16_t*)(wl + WO_O), D, TMP, D, M, D, D);
            hipLaunchKernelGGL(k_resid, dim3(M * D / 256), dim3(256), 0, stream, xin, (const float*)TMP, X, (size_t)M * D); break;
    case 5: hipLaunchKernelGGL(k_rmsnorm, dim3(1024), dim3(256), 0, stream, (const float*)X, P.in[9] + (size_t)l * D, XN, (float*)nullptr); break;
    case 6: gemm_naive(stream, XN, D, (const bf16_t*)(wl + WO_GU), D, TMP, GUW, M, GUW, D);
            hipLaunchKernelGGL(k_swiglu, dim3((unsigned)(((size_t)M * DFF + 255) / 256)), dim3(256), 0, stream, P); break;
    case 7: gemm_naive(stream, (const bf16_t*)(ws + WS_H), DFF, (const bf16_t*)(wl + WO_D), DFF, TMP, D, M, D, DFF);
            hipLaunchKernelGGL(k_resid, dim3(M * D / 256), dim3(256), 0, stream, (const float*)X, (const float*)TMP, X, (size_t)M * D); break;
    default: if (l + 1 < DEPTH) hipLaunchKernelGGL(k_rmsnorm, dim3(1024), dim3(256), 0, stream, (const float*)X, P.in[2] + (size_t)(l + 1) * D, XN, (float*)nullptr);
             else hipLaunchKernelGGL(k_rmsnorm, dim3(1024), dim3(256), 0, stream, (const float*)X, P.in[12], (bf16_t*)nullptr, P.out); break;
    }
}
#endif
static void launch_fwd(hipStream_t stream, int grid, Args a, int lo, int hi, int li) {
    a.ph_lo = lo; a.ph_hi = hi; a.li = li; a.pad = 0;
    hipLaunchKernelGGL(fwd, dim3(grid), dim3(NWAVES * 64), LDS_BYTES, stream, a);
    const hipError_t le = hipPeekAtLastError();
    if (le != hipSuccess) fprintf(stderr, "kernel_launch: launch of phases [%d,%d) failed: %s (grid %d x %d threads, %d B LDS)\n", lo, hi, hipGetErrorName(le), grid, NWAVES * 64, LDS_BYTES);
}
extern "C" void kernel_launch(void* const* d_in, const int* in_sizes, int n_in, void* d_out, int out_size, void* d_ws, size_t ws_size, hipStream_t stream) {
    static int grid = 0;
    if (grid == 0) {
        const size_t need = MK_NAIVE_MASK ? WS_TMP + 352 * MiB : WS_BEND;
        if (n_in != 13 || in_sizes[0] != M * D || out_size != M * D || ws_size < need) { fprintf(stderr, "kernel_launch: built for 13 inputs, x/out of %d floats and >= %zu bytes of workspace; got n_in %d, ws %zu; nothing launched\n", M * D, need, n_in, ws_size); grid = -1; return; }
        int dev = 0, cus = 0, per_cu = 0;
        if (hipGetDevice(&dev) != hipSuccess || hipDeviceGetAttribute(&cus, hipDeviceAttributeMultiprocessorCount, dev) != hipSuccess) { fprintf(stderr, "kernel_launch: device query failed\n"); grid = -1; return; }
        if (hipFuncSetAttribute((const void*)fwd, hipFuncAttributeMaxDynamicSharedMemorySize, LDS_BYTES) != hipSuccess) { fprintf(stderr, "kernel_launch: hipFuncSetAttribute failed\n"); grid = -1; return; }
        if (hipOccupancyMaxActiveBlocksPerMultiprocessor(&per_cu, (const void*)fwd, NWAVES * 64, LDS_BYTES) != hipSuccess || per_cu < 1) { fprintf(stderr, "kernel_launch: occupancy query says %d workgroups per CU; nothing launched\n", per_cu); grid = -1; (void)hipGetLastError(); return; }
        grid = cus;
    }
    if (grid < 0) return;
    if (hipMemsetAsync((char*)d_ws + WS_CTL, 0, CTL_ZERO_BYTES, stream) != hipSuccess) { fprintf(stderr, "kernel_launch: memset failed\n"); return; }
    Args a{};
    for (int i = 0; i < 13; ++i) a.in[i] = (const float*)d_in[i];
    a.out = (float*)d_out; a.ws = (unsigned char*)d_ws;
#if MK_LAUNCHES == 1
    launch_fwd(stream, grid, a, 0, NPHASES, 0);
#else
#if MK_NAIVE_MASK
    Ptrs P{}; for (int i = 0; i < 13; ++i) P.in[i] = a.in[i]; P.out = a.out; P.ws = a.ws;
#endif
    int li = 0;
#if MK_NAIVE_MASK & 512
    hipLaunchKernelGGL(k_prologue_naive, dim3(2048), dim3(256), 0, stream, P);
    hipLaunchKernelGGL(k_rmsnorm, dim3(1024), dim3(256), 0, stream, P.in[0], P.in[2], (bf16_t*)(P.ws + WS_XN), (float*)nullptr);
#else
    launch_fwd(stream, grid, a, 0, 1, li++);
#endif
    for (int l = 0; l < DEPTH; ++l)
        for (int p = 0; p < NPH_L; ++p) {
#if MK_NAIVE_MASK
            if ((MK_NAIVE_MASK >> p) & 1) { naive_stage(stream, P, l, p); continue; }
#endif
            launch_fwd(stream, grid, a, 1 + l * NPH_L + p, 2 + l * NPH_L + p, li++);
        }
#endif
}
```
